# Optimizing an MI355X kernel written in HIP

```python
import jax, jax.numpy as jnp
from jax import lax
import numpy as np

D_MODEL = 1024
BATCH = 8
SEQ = 4096
DEPTH = 4
DEC_BATCH = 32
DEC_SEQ = 64
PAST_LEN = 2048

CHUNK = 64
N_MIXERS = 3
N_A = (DEPTH + 2) // 3
N_B = (DEPTH + 1) // 3
N_C = DEPTH // 3
NORM_EPS = 1e-6
NEG_INF = -1e30

A_HEADS = 8
A_HEAD_DIM = D_MODEL // A_HEADS
A_WIDTH = A_HEADS * A_HEAD_DIM
A_BAND_CHUNKS = 9
A_REACH = (A_BAND_CHUNKS - 1) * CHUNK
A_REL_CLIP = 128

B_HEADS = 16
B_KV_HEADS = 4
B_HEAD_DIM = D_MODEL // B_HEADS
B_GROUP = B_HEADS // B_KV_HEADS
B_WIDTH = B_HEADS * B_HEAD_DIM
B_KV_WIDTH = B_KV_HEADS * B_HEAD_DIM
B_WINDOW = 128
B_BAND_CHUNKS = B_WINDOW // CHUNK + 1
B_REACH = B_WINDOW

C_HEADS = 16
C_NOPE = 64
C_ROPE = 32
C_QK = C_NOPE + C_ROPE
C_V = 64
C_Q_LORA = 512
C_KV_LORA = 256
C_WIDTH = C_HEADS * C_V
C_QBLOCK = 128
ROPE_THETA = 10000.0

kernel_name = 'hybrid_stream_encoder_step'


def rmsnorm(x, g):
    xf = x.astype(jnp.float32)
    y = xf * lax.rsqrt(jnp.mean(xf * xf, axis=-1, keepdims=True) + NORM_EPS)
    return (y * g.astype(jnp.float32)).astype(x.dtype)


def rope(x, pos):
    half = x.shape[-1] // 2
    inv = ROPE_THETA ** (-jnp.arange(half, dtype=jnp.float32) / half)
    ang = pos.astype(jnp.float32)[:, None] * inv[None, :]
    shape = (1, x.shape[1]) + (1,) * (x.ndim - 3) + (half,)
    cos = jnp.cos(ang).reshape(shape).astype(x.dtype)
    sin = jnp.sin(ang).reshape(shape).astype(x.dtype)
    x1, x2 = x[..., :half], x[..., half:]
    return jnp.concatenate([x1 * cos - x2 * sin, x1 * sin + x2 * cos], axis=-1)


def alibi_slopes(n):
    return 2.0 ** (-8.0 * jnp.arange(1, n + 1, dtype=jnp.float32) / n)


def attend(q, k, v, scale, bias=None, mask=None, sinks=None):
    s = jnp.einsum('bqhgd,bkhd->bhgqk', q, k).astype(jnp.float32) * scale
    if bias is not None:
        s = s + bias
    if mask is not None:
        s = jnp.where(mask, s, NEG_INF)
    if sinks is None:
        p = jax.nn.softmax(s, axis=-1)
    else:
        sk = sinks.astype(jnp.float32)[None, :, :, None, None]
        m = jnp.maximum(jnp.max(s, axis=-1, keepdims=True), sk)
        e = jnp.exp(s - m)
        p = e / (jnp.sum(e, axis=-1, keepdims=True) + jnp.exp(sk - m))
    return jnp.einsum('bhgqk,bkhe->bqhge', p.astype(v.dtype), v)


def band_attend_prompt(q, k, v, n_band, bias_fn, scale, sinks=None):
    n, s = q.shape[0], q.shape[1]
    pad = (n_band - 1) * CHUNK
    span = n_band * CHUNK
    kp = jnp.pad(k, ((0, 0), (pad, 0), (0, 0), (0, 0)))
    vp = jnp.pad(v, ((0, 0), (pad, 0), (0, 0), (0, 0)))
    kpos = jnp.arange(span)
    bias = bias_fn((pad + jnp.arange(CHUNK))[:, None] - kpos[None, :])

    def one_chunk(c):
        start = c * CHUNK
        qb = lax.dynamic_slice_in_dim(q, start, CHUNK, axis=1)
        kb = lax.dynamic_slice_in_dim(kp, start, span, axis=1)
        vb = lax.dynamic_slice_in_dim(vp, start, span, axis=1)
        valid = (start - pad + kpos) >= 0
        return attend(qb, kb, vb, scale, bias, valid[None, :], sinks)

    out = lax.map(one_chunk, jnp.arange(s // CHUNK))
    return jnp.moveaxis(out, 0, 1).reshape((n, s) + out.shape[3:])


def band_attend_sample(q, k_cache, v_cache, k_new, v_new, bias_fn, scale, sinks=None):
    k = jnp.concatenate([k_cache, k_new], axis=1)
    v = jnp.concatenate([v_cache, v_new], axis=1)
    l, t = k_cache.shape[1], q.shape[1]
    d = (l + jnp.arange(t))[:, None] - jnp.arange(l + t)[None, :]
    return attend(q, k, v, scale, bias_fn(d), None, sinks), k, v


def chunk_causal_attend_prompt(q, k, v, scale):
    n, s = q.shape[0], q.shape[1]
    kchunk = jnp.arange(s) // CHUNK

    def one_block(i):
        start = i * C_QBLOCK
        qb = lax.dynamic_slice_in_dim(q, start, C_QBLOCK, axis=1)
        qchunk = (start + jnp.arange(C_QBLOCK)) // CHUNK
        mask = kchunk[None, :] <= qchunk[:, None]
        return attend(qb, k, v, scale, None, mask)

    out = lax.map(one_block, jnp.arange(s // C_QBLOCK))
    return jnp.moveaxis(out, 0, 1).reshape((n, s) + out.shape[3:])


def gated_out(o, g, w_out):
    return (o.reshape(g.shape) * jax.nn.silu(g)) @ w_out


def mixer_a(xp, xs, ck, cv, norm_g, w_in, q_g, k_g, rel, w_out):
    scale = A_HEAD_DIM ** -0.5

    def bias_fn(d):
        idx = jnp.clip(d, -A_REL_CLIP, A_REL_CLIP) + A_REL_CLIP
        return rel.astype(jnp.float32)[:, idx][:, None]

    def proj(x):
        n, s = x.shape[0], x.shape[1]
        z = rmsnorm(x, norm_g) @ w_in
        q, k, v, g = jnp.split(z, 4, axis=-1)
        q = rmsnorm(q.reshape(n, s, A_HEADS, 1, A_HEAD_DIM), q_g)
        k = rmsnorm(k.reshape(n, s, A_HEADS, A_HEAD_DIM), k_g)
        v = v.reshape(n, s, A_HEADS, A_HEAD_DIM)
        return q, k, v, g

    qp, kp, vp, gp = proj(xp)
    op = band_attend_prompt(qp, kp, vp, A_BAND_CHUNKS, bias_fn, scale)
    qs, ks, vs, gs = proj(xs)
    os_, kall, vall = band_attend_sample(qs, ck, cv, ks, vs, bias_fn, scale)
    return (gated_out(op, gp, w_out), gated_out(os_, gs, w_out),
            kp[:, -A_REACH:], vp[:, -A_REACH:], kall[:, -A_REACH:], vall[:, -A_REACH:])


def mixer_b(xp, xs, ck, cv, norm_g, w_in, q_g, k_g, sinks, w_out):
    scale = B_HEAD_DIM ** -0.5
    slopes = alibi_slopes(B_HEADS)[:, None, None]
    snk = sinks.reshape(B_KV_HEADS, B_GROUP)

    def bias_fn(d):
        return (-slopes * jnp.abs(d).astype(jnp.float32)).reshape(B_KV_HEADS, B_GROUP, d.shape[0], d.shape[1])

    def proj(x):
        n, s = x.shape[0], x.shape[1]
        z = rmsnorm(x, norm_g) @ w_in
        o1 = B_WIDTH
        o2 = o1 + B_KV_WIDTH
        o3 = o2 + B_KV_WIDTH
        q = rmsnorm(z[..., :o1].reshape(n, s, B_KV_HEADS, B_GROUP, B_HEAD_DIM), q_g)
        k = rmsnorm(z[..., o1:o2].reshape(n, s, B_KV_HEADS, B_HEAD_DIM), k_g)
        v = z[..., o2:o3].reshape(n, s, B_KV_HEADS, B_HEAD_DIM)
        return q, k, v, z[..., o3:]

    qp, kp, vp, gp = proj(xp)
    op = band_attend_prompt(qp, kp, vp, B_BAND_CHUNKS, bias_fn, scale, snk)
    qs, ks, vs, gs = proj(xs)
    os_, kall, vall = band_attend_sample(qs, ck, cv, ks, vs, bias_fn, scale, snk)
    return (gated_out(op, gp, w_out), gated_out(os_, gs, w_out),
            kp[:, -B_REACH:], vp[:, -B_REACH:], kall[:, -B_REACH:], vall[:, -B_REACH:])


def mixer_c(xp, xs, ckv_cache, ckr_cache, norm_g, w_in, qa_g, w_qb, kva_g, w_kvb, q_g, k_g, w_out):
    scale = C_QK ** -0.5

    def proj(x, pos):
        n, s = x.shape[0], x.shape[1]
        z = rmsnorm(x, norm_g) @ w_in
        o1 = C_Q_LORA
        o2 = o1 + C_KV_LORA
        o3 = o2 + C_ROPE
        q = (rmsnorm(z[..., :o1], qa_g) @ w_qb).reshape(n, s, C_HEADS, 1, C_QK)
        q = jnp.concatenate([rmsnorm(q[..., :C_NOPE], q_g[:C_NOPE]),
                             rope(rmsnorm(q[..., C_NOPE:], q_g[C_NOPE:]), pos)], axis=-1)
        ckv = rmsnorm(z[..., o1:o2], kva_g)
        kr = rope(rmsnorm(z[..., o2:o3], k_g[C_NOPE:]), pos)
        return q, ckv, kr, z[..., o3:]

    def expand(ckv, kr):
        n, s = ckv.shape[0], ckv.shape[1]
        kv = (ckv @ w_kvb).reshape(n, s, C_HEADS, C_NOPE + C_V)
        k = jnp.concatenate([rmsnorm(kv[..., :C_NOPE], k_g[:C_NOPE]),
                             jnp.broadcast_to(kr[:, :, None, :], (n, s, C_HEADS, C_ROPE))], axis=-1)
        return k, kv[..., C_NOPE:]

    qp, ckv_p, kr_p, gp = proj(xp, jnp.arange(xp.shape[1]))
    kp, vp = expand(ckv_p, kr_p)
    op = chunk_causal_attend_prompt(qp, kp, vp, scale)
    past = ckv_cache.shape[1]
    qs, ckv_s, kr_s, gs = proj(xs, past + jnp.arange(xs.shape[1]))
    ks, vs = expand(jnp.concatenate([ckv_cache, ckv_s], axis=1), jnp.concatenate([ckr_cache, kr_s], axis=1))
    os_ = attend(qs, ks, vs, scale)
    return (gated_out(op, gp, w_out), gated_out(os_, gs, w_out), ckv_p, kr_p, ckv_s, kr_s)


def setup_inputs(seed: int = 0) -> dict:
    key = jax.random.key(seed)
    keys = iter(jax.random.split(key, 40))

    def nrm(shape, scale=1.0):
        return jax.random.normal(next(keys), shape, jnp.float32) * scale

    def gain(shape):
        return 1.0 + 0.02 * nrm(shape)

    la = min(A_REACH, PAST_LEN)
    lb = min(B_REACH, PAST_LEN)
    return {
        'x_prompt': nrm((BATCH, SEQ, D_MODEL)),
        'x_sample': nrm((DEC_BATCH, DEC_SEQ, D_MODEL)),
        'cache_a_k': nrm((N_A, DEC_BATCH, la, A_HEADS, A_HEAD_DIM)),
        'cache_a_v': nrm((N_A, DEC_BATCH, la, A_HEADS, A_HEAD_DIM)),
        'cache_b_k': nrm((N_B, DEC_BATCH, lb, B_KV_HEADS, B_HEAD_DIM)),
        'cache_b_v': nrm((N_B, DEC_BATCH, lb, B_KV_HEADS, B_HEAD_DIM)),
        'cache_c_kv': nrm((N_C, DEC_BATCH, PAST_LEN, C_KV_LORA)),
        'cache_c_kr': nrm((N_C, DEC_BATCH, PAST_LEN, C_ROPE)),
        'a_norm': gain((N_A, D_MODEL)),
        'a_w_in': nrm((N_A, D_MODEL, 4 * A_WIDTH), D_MODEL ** -0.5),
        'a_q_norm': gain((N_A, A_HEAD_DIM)),
        'a_k_norm': gain((N_A, A_HEAD_DIM)),
        'a_rel_bias': nrm((N_A, A_HEADS, 2 * A_REL_CLIP + 1), 0.5),
        'a_w_out': nrm((N_A, A_WIDTH, D_MODEL), A_WIDTH ** -0.5),
        'b_norm': gain((N_B, D_MODEL)),
        'b_w_in': nrm((N_B, D_MODEL, 2 * B_WIDTH + 2 * B_KV_WIDTH), D_MODEL ** -0.5),
        'b_q_norm': gain((N_B, B_HEAD_DIM)),
        'b_k_norm': gain((N_B, B_HEAD_DIM)),
        'b_sinks': nrm((N_B, B_HEADS), 0.5),
        'b_w_out': nrm((N_B, B_WIDTH, D_MODEL), B_WIDTH ** -0.5),
        'c_norm': gain((N_C, D_MODEL)),
        'c_w_in': nrm((N_C, D_MODEL, C_Q_LORA + C_KV_LORA + C_ROPE + C_WIDTH), D_MODEL ** -0.5),
        'c_q_a_norm': gain((N_C, C_Q_LORA)),
        'c_w_qb': nrm((N_C, C_Q_LORA, C_HEADS * C_QK), C_Q_LORA ** -0.5),
        'c_kv_a_norm': gain((N_C, C_KV_LORA)),
        'c_w_kvb': nrm((N_C, C_KV_LORA, C_HEADS * (C_NOPE + C_V)), C_KV_LORA ** -0.5),
        'c_q_norm': gain((N_C, C_QK)),
        'c_k_norm': gain((N_C, C_QK)),
        'c_w_out': nrm((N_C, C_WIDTH, D_MODEL), C_WIDTH ** -0.5),
    }


def reference(x_prompt, x_sample, cache_a_k, cache_a_v, cache_b_k, cache_b_v, cache_c_kv, cache_c_kr,
              a_norm, a_w_in, a_q_norm, a_k_norm, a_rel_bias, a_w_out,
              b_norm, b_w_in, b_q_norm, b_k_norm, b_sinks, b_w_out,
              c_norm, c_w_in, c_q_a_norm, c_w_qb, c_kv_a_norm, c_w_kvb, c_q_norm, c_k_norm, c_w_out):
    xp, xs = x_prompt, x_sample
    ak_p, av_p, ak_s, av_s = [], [], [], []
    bk_p, bv_p, bk_s, bv_s = [], [], [], []
    ckv_p, ckr_p, ckv_s, ckr_s = [], [], [], []
    for i in range(DEPTH):
        j = i // N_MIXERS
        kind = i % N_MIXERS
        if kind == 0:
            dp, ds, s0, s1, s2, s3 = mixer_a(xp, xs, cache_a_k[j], cache_a_v[j], a_norm[j], a_w_in[j],
                                             a_q_norm[j], a_k_norm[j], a_rel_bias[j], a_w_out[j])
            ak_p.append(s0); av_p.append(s1); ak_s.append(s2); av_s.append(s3)
        elif kind == 1:
            dp, ds, s0, s1, s2, s3 = mixer_b(xp, xs, cache_b_k[j], cache_b_v[j], b_norm[j], b_w_in[j],
                                             b_q_norm[j], b_k_norm[j], b_sinks[j], b_w_out[j])
            bk_p.append(s0); bv_p.append(s1); bk_s.append(s2); bv_s.append(s3)
        else:
            dp, ds, s0, s1, s2, s3 = mixer_c(xp, xs, cache_c_kv[j], cache_c_kr[j], c_norm[j], c_w_in[j],
                                             c_q_a_norm[j], c_w_qb[j], c_kv_a_norm[j], c_w_kvb[j],
                                             c_q_norm[j], c_k_norm[j], c_w_out[j])
            ckv_p.append(s0); ckr_p.append(s1); ckv_s.append(s2); ckr_s.append(s3)
        xp = xp + dp
        xs = xs + ds
    return (xp, xs,
            jnp.stack(ak_p), jnp.stack(av_p), jnp.stack(bk_p), jnp.stack(bv_p), jnp.stack(ckv_p), jnp.stack(ckr_p),
            jnp.stack(ak_s), jnp.stack(av_s), jnp.stack(bk_s), jnp.stack(bv_s), jnp.stack(ckv_s), jnp.stack(ckr_s))
```

```cpp
#include <hip/hip_runtime.h>
#include <hip/hip_cooperative_groups.h>
#include <cstdio>
#include <cstdint>
namespace cg = cooperative_groups;

#ifndef MODE_COOP
#define MODE_COOP 1
#endif

#define DI __device__ __forceinline__
typedef unsigned short bf16_t;
using bf16x8 = __attribute__((ext_vector_type(8))) short;
using s16x4  = __attribute__((ext_vector_type(4))) short;
using f32x16 = __attribute__((ext_vector_type(16))) float;
using f32x4  = __attribute__((ext_vector_type(4))) float;
using u32x4  = __attribute__((ext_vector_type(4))) unsigned;
using u32x2  = __attribute__((ext_vector_type(2))) unsigned;
typedef __bf16 bf2_t __attribute__((ext_vector_type(2)));
typedef float f2_t __attribute__((ext_vector_type(2)));
#define MFMA(a, b, c) __builtin_amdgcn_mfma_f32_32x32x16_bf16((a), (b), (c), 0, 0, 0)

DI unsigned pk2(float lo, float hi) { f2_t v = {lo, hi}; return __builtin_bit_cast(unsigned, __builtin_convertvector(v, bf2_t)); }
DI float bf_lo(unsigned u) { return __uint_as_float(u << 16); }
DI float bf_hi(unsigned u) { return __uint_as_float(u & 0xffff0000u); }
DI int crow(int i, int h) { return (i & 3) + 8 * (i >> 2) + 4 * h; }
DI float wave_sum(float v) {
#pragma unroll
  for (int o = 32; o >= 1; o >>= 1) v += __shfl_xor(v, o);
  return v;
}
DI float fast_exp2(float x) { return __builtin_amdgcn_exp2f(x); }
DI float silu(float g) { return g / (1.f + __expf(-g)); }

constexpr int DM = 1024;
constexpr int SEQ = 4096, PB = 8, SBATCH = 32, DSEQ = 64, PAST = 2048;
constexpr int NP = PB * SEQ;
constexpr int NS = SBATCH * DSEQ;
constexpr int NT = NP + NS;
constexpr float EPS = 1e-6f;
constexpr float LOG2E = 1.4426950408889634f;
constexpr float QS_A = 0.08838834764831845f * LOG2E;
constexpr float QS_B = 0.125f * LOG2E;
constexpr float QS_C = 0.10206207261596575f * LOG2E;
constexpr int CKEYS = PAST + DSEQ;
constexpr int CROUND_B = 16;

constexpr size_t O_Y      = 0;
constexpr size_t O_AKP    = O_Y + (size_t)NT * DM;
constexpr size_t O_AVP    = O_AKP + 8388608;
constexpr size_t O_BKP    = O_AVP + 8388608;
constexpr size_t O_BVP    = O_BKP + 262144;
constexpr size_t O_CKVP   = O_BVP + 262144;
constexpr size_t O_CKRP   = O_CKVP + 8388608;
constexpr size_t O_AKS    = O_CKRP + 1048576;
constexpr size_t O_AVS    = O_AKS + 33554432;
constexpr size_t O_BKS    = O_AVS + 33554432;
constexpr size_t O_BVS    = O_BKS + 1048576;
constexpr size_t O_CKVS   = O_BVS + 1048576;
constexpr size_t O_CKRS   = O_CKVS + 524288;
constexpr size_t O_END    = O_CKRS + 65536;
static_assert(O_END == 132186112, "output size");

constexpr size_t WS_WAIN  = 0;
constexpr size_t WS_WAOUT = WS_WAIN + 2 * 8388608;
constexpr size_t WS_WBIN  = WS_WAOUT + 2 * 2097152;
constexpr size_t WS_WBOUT = WS_WBIN + 5242880;
constexpr size_t WS_WCIN  = WS_WBOUT + 2097152;
constexpr size_t WS_WCQB  = WS_WCIN + 3932160;
constexpr size_t WS_WCKVB = WS_WCQB + 1572864;
constexpr size_t WS_WCOUT = WS_WCKVB + 1048576;
constexpr size_t WS_ROPE  = WS_WCOUT + 2097152;
constexpr size_t WS_SG    = WS_ROPE + 524288;
constexpr size_t WS_X     = WS_SG + (size_t)NT * DM * 2;
constexpr size_t WS_L     = WS_X + (size_t)NT * DM * 2;
constexpr size_t WS_AQ    = WS_L;
constexpr size_t WS_AKP   = WS_AQ + (size_t)NT * DM * 2;
constexpr size_t WS_AKS   = WS_AKP + (size_t)NP * DM * 2;
constexpr size_t WS_AVTP  = WS_AKS + (size_t)32 * 576 * 1024 * 2;
constexpr size_t WS_AVTS  = WS_AVTP + (size_t)NP * DM * 2;
constexpr size_t WS_AEND  = WS_AVTS + (size_t)32 * 576 * 1024 * 2;
constexpr size_t WS_BQ    = WS_L;
constexpr size_t WS_BKP   = WS_BQ + (size_t)NT * DM * 2;
constexpr size_t WS_BKS   = WS_BKP + (size_t)NP * 256 * 2;
constexpr size_t WS_BVTP  = WS_BKS + (size_t)32 * 192 * 256 * 2;
constexpr size_t WS_BVTS  = WS_BVTP + (size_t)NP * 256 * 2;
constexpr size_t WS_BEND  = WS_BVTS + (size_t)32 * 192 * 256 * 2;
constexpr size_t WS_CZ    = WS_L;
constexpr size_t WS_CQ    = WS_L;
constexpr size_t WS_CCKVP = WS_CZ + (size_t)NT * 800 * 4;
constexpr size_t WS_CKRP  = WS_CCKVP + (size_t)NP * 256 * 2;
constexpr size_t WS_CKRS  = WS_CKRP + (size_t)NP * 32 * 2;
constexpr size_t WS_CKNS  = WS_CKRS + (size_t)32 * CKEYS * 32 * 2;
constexpr size_t WS_CVTS  = WS_CKNS + (size_t)CROUND_B * 16 * CKEYS * 64 * 2;
constexpr size_t WS_CEND  = WS_CVTS + (size_t)CROUND_B * 16 * CKEYS * 64 * 2;
constexpr size_t WS_CQA   = WS_X;
constexpr size_t WS_CCKVS = WS_CQA + (size_t)NT * 512 * 2;
static_assert(WS_CCKVS + (size_t)32 * CKEYS * 256 * 2 <= WS_L, "QA + CKVs must fit in X region");
static_assert((size_t)NT * 1536 * 2 <= (size_t)NT * 800 * 4, "Qc fits in Z region");
constexpr size_t WS_NEED  = WS_AEND > WS_CEND ? (WS_AEND > WS_BEND ? WS_AEND : WS_BEND) : (WS_CEND > WS_BEND ? WS_CEND : WS_BEND);
constexpr size_t O_SCR_KNP = O_AKS + 16777216;
constexpr size_t O_SCR_VTP = O_AVS + 16777216;

struct Params {
  const float* in[29];
  float* out;
  unsigned char* ws;
  int ph_lo, ph_hi;
};

constexpr int LDS_BYTES = 73728;
constexpr int G_STR = 144;
constexpr int G_TILE = 128 * G_STR;
constexpr int C_STR = 132;
static_assert(4 * G_TILE <= LDS_BYTES && 128 * C_STR * 4 <= LDS_BYTES, "lds");

DI void gemm_tile_to_lds(unsigned char* lds, const bf16_t* __restrict__ A, long lda, const bf16_t* __restrict__ Bt, long ldb, int K) {
  const int t = threadIdx.x, lane = t & 63, w = t >> 6, r = lane & 31, h = lane >> 5;
  const int wm = w >> 1, wn = w & 1;
  const int lrow = t >> 3, lch = t & 7;
  const bf16_t* ap = A + (long)lrow * lda + lch * 8;
  const bf16_t* bp = Bt + (long)lrow * ldb + lch * 8;
  u32x4 ra[4], rb[4];
  f32x16 acc00 = {}, acc01 = {}, acc10 = {}, acc11 = {};
  const int nk = K >> 6;
#pragma unroll
  for (int i = 0; i < 4; ++i) { ra[i] = *(const u32x4*)(ap + (long)(32 * i) * lda); rb[i] = *(const u32x4*)(bp + (long)(32 * i) * ldb); }
  __syncthreads();
#pragma unroll
  for (int i = 0; i < 4; ++i) {
    *(u32x4*)(lds + (lrow + 32 * i) * G_STR + lch * 16) = ra[i];
    *(u32x4*)(lds + 2 * G_TILE + (lrow + 32 * i) * G_STR + lch * 16) = rb[i];
  }
  __syncthreads();
  for (int kt = 0; kt < nk; ++kt) {
    const int buf = kt & 1;
    if (kt + 1 < nk) {
#pragma unroll
      for (int i = 0; i < 4; ++i) {
        ra[i] = *(const u32x4*)(ap + (long)(32 * i) * lda + (kt + 1) * 64);
        rb[i] = *(const u32x4*)(bp + (long)(32 * i) * ldb + (kt + 1) * 64);
      }
    }
    const unsigned char* ab = lds + buf * G_TILE + (wm * 64 + r) * G_STR + h * 16;
    const unsigned char* bb = lds + 2 * G_TILE + buf * G_TILE + (wn * 64 + r) * G_STR + h * 16;
#pragma unroll
    for (int ks = 0; ks < 4; ++ks) {
      bf16x8 a0 = *(const bf16x8*)(ab + ks * 32);
      bf16x8 a1 = *(const bf16x8*)(ab + 32 * G_STR + ks * 32);
      bf16x8 b0 = *(const bf16x8*)(bb + ks * 32);
      bf16x8 b1 = *(const bf16x8*)(bb + 32 * G_STR + ks * 32);
      acc00 = MFMA(a0, b0, acc00); acc01 = MFMA(a0, b1, acc01);
      acc10 = MFMA(a1, b0, acc10); acc11 = MFMA(a1, b1, acc11);
    }
    if (kt + 1 < nk) {
      const int nb = buf ^ 1;
#pragma unroll
      for (int i = 0; i < 4; ++i) {
        *(u32x4*)(lds + nb * G_TILE + (lrow + 32 * i) * G_STR + lch * 16) = ra[i];
        *(u32x4*)(lds + 2 * G_TILE + nb * G_TILE + (lrow + 32 * i) * G_STR + lch * 16) = rb[i];
      }
    }
    __syncthreads();
  }
  float* Cs = (float*)lds;
#pragma unroll
  for (int i = 0; i < 16; ++i) {
    const int rr = crow(i, h);
    Cs[(wm * 64 + rr) * C_STR + wn * 64 + r] = acc00[i];
    Cs[(wm * 64 + rr) * C_STR + wn * 64 + 32 + r] = acc01[i];
    Cs[(wm * 64 + 32 + rr) * C_STR + wn * 64 + r] = acc10[i];
    Cs[(wm * 64 + 32 + rr) * C_STR + wn * 64 + 32 + r] = acc11[i];
  }
  __syncthreads();
}

DI float row_sumsq(const float* rp, int n4) {
  float ss = 0.f;
  for (int j = 0; j < n4; ++j) { f32x4 v = *(const f32x4*)(rp + 4 * j); ss += v[0] * v[0] + v[1] * v[1] + v[2] * v[2] + v[3] * v[3]; }
  return ss;
}
DI void norm_store64(const float* rp, const float* __restrict__ g, float sc, bf16_t* dst, float fsc, float* fdst) {
#pragma unroll
  for (int j = 0; j < 8; ++j) {
    f32x4 v0 = *(const f32x4*)(rp + 8 * j), v1 = *(const f32x4*)(rp + 8 * j + 4);
    f32x4 g0 = *(const f32x4*)(g + 8 * j), g1 = *(const f32x4*)(g + 8 * j + 4);
    f32x4 x0 = v0 * g0, x1 = v1 * g1;
    u32x4 o = {pk2(x0[0] * sc, x0[1] * sc), pk2(x0[2] * sc, x0[3] * sc), pk2(x1[0] * sc, x1[1] * sc), pk2(x1[2] * sc, x1[3] * sc)};
    *(u32x4*)(dst + 8 * j) = o;
    if (fdst) { *(f32x4*)(fdst + 8 * j) = x0 * fsc; *(f32x4*)(fdst + 8 * j + 4) = x1 * fsc; }
  }
}
DI void raw_store64_f32(const float* rp, float* fdst) {
#pragma unroll
  for (int j = 0; j < 16; ++j) *(f32x4*)(fdst + 4 * j) = *(const f32x4*)(rp + 4 * j);
}
DI void silu_store64(const float* rp, bf16_t* dst) {
#pragma unroll
  for (int j = 0; j < 8; ++j) {
    f32x4 v0 = *(const f32x4*)(rp + 8 * j), v1 = *(const f32x4*)(rp + 8 * j + 4);
    u32x4 o = {pk2(silu(v0[0]), silu(v0[1])), pk2(silu(v0[2]), silu(v0[3])), pk2(silu(v1[0]), silu(v1[1])), pk2(silu(v1[2]), silu(v1[3]))};
    *(u32x4*)(dst + 8 * j) = o;
  }
}
DI void tr_store64(const float* Cs, int col, int rh, bf16_t* dst) {
#pragma unroll
  for (int g = 0; g < 8; ++g) {
    const float* p = Cs + (rh * 64 + g * 8) * C_STR + col;
    u32x4 o = {pk2(p[0], p[C_STR]), pk2(p[2 * C_STR], p[3 * C_STR]), pk2(p[4 * C_STR], p[5 * C_STR]), pk2(p[6 * C_STR], p[7 * C_STR])};
    *(u32x4*)(dst + g * 8) = o;
  }
}

struct Ctx {
  const float* const* in;
  float* out;
  unsigned char* ws;
  DI const float* xin_row(int layer, int row) const {
    if (layer == 0) return row < NP ? in[0] + (size_t)row * DM : in[1] + (size_t)(row - NP) * DM;
    return out + (size_t)row * DM;
  }
  template <class T> DI T* wsp(size_t off) const { return (T*)(ws + off); }
};

template <class Perm>
DI void wt_job(const float* __restrict__ W, int K, int N, bf16_t* __restrict__ Wt, int Np, Perm perm, long gtid, long gsz) {
  const long items = (long)Np * (K / 8);
  for (long idx = gtid; idx < items; idx += gsz) {
    const int np = (int)(idx % Np), kg = (int)(idx / Np);
    const int n = perm(np);
    u32x4 o = {0u, 0u, 0u, 0u};
    if (n >= 0) {
      const float* p = W + (size_t)(kg * 8) * N + n;
      o = (u32x4){pk2(p[0], p[(size_t)N]), pk2(p[(size_t)2 * N], p[(size_t)3 * N]), pk2(p[(size_t)4 * N], p[(size_t)5 * N]), pk2(p[(size_t)6 * N], p[(size_t)7 * N])};
    }
    *(u32x4*)(Wt + (size_t)np * K + kg * 8) = o;
  }
}
__constant__ float ROPE_INV[16] = {1.000000000e+00f, 5.623413324e-01f, 3.162277639e-01f, 1.778279394e-01f, 1.000000015e-01f, 5.623413250e-02f,
                                   3.162277490e-02f, 1.778279431e-02f, 9.999999776e-03f, 5.623413250e-03f, 3.162277630e-03f, 1.778279431e-03f,
                                   1.000000047e-03f, 5.623413017e-04f, 3.162277571e-04f, 1.778279402e-04f};
DI void phase_prep(const Ctx& c) {
  const long gtid = (long)blockIdx.x * 256 + threadIdx.x, gsz = (long)gridDim.x * 256;
  auto ident = [](int n) { return n; };
  for (int j = 0; j < 2; ++j) {
    wt_job(c.in[9] + (size_t)j * 1024 * 4096, 1024, 4096, c.wsp<bf16_t>(WS_WAIN) + (size_t)j * 4096 * 1024, 4096, ident, gtid, gsz);
    wt_job(c.in[13] + (size_t)j * 1024 * 1024, 1024, 1024, c.wsp<bf16_t>(WS_WAOUT) + (size_t)j * 1024 * 1024, 1024, ident, gtid, gsz);
  }
  wt_job(c.in[15], 1024, 2560, c.wsp<bf16_t>(WS_WBIN), 2560, ident, gtid, gsz);
  wt_job(c.in[19], 1024, 1024, c.wsp<bf16_t>(WS_WBOUT), 1024, ident, gtid, gsz);
  wt_job(c.in[21], 1024, 1824, c.wsp<bf16_t>(WS_WCIN), 1920, [](int n) { return n < 1024 ? 800 + n : (n < 1824 ? n - 1024 : -1); }, gtid, gsz);
  wt_job(c.in[23], 512, 1536, c.wsp<bf16_t>(WS_WCQB), 1536,
         [](int n) { return n < 1024 ? (n >> 6) * 96 + (n & 63) : ((n - 1024) >> 5) * 96 + 64 + ((n - 1024) & 31); }, gtid, gsz);
  wt_job(c.in[25], 256, 2048, c.wsp<bf16_t>(WS_WCKVB), 2048,
         [](int n) { return n < 1024 ? (n >> 6) * 128 + (n & 63) : ((n - 1024) >> 6) * 128 + 64 + ((n - 1024) & 63); }, gtid, gsz);
  wt_job(c.in[28], 1024, 1024, c.wsp<bf16_t>(WS_WCOUT), 1024, ident, gtid, gsz);
  float* rope = c.wsp<float>(WS_ROPE);
  for (long idx = gtid; idx < 4096 * 16; idx += gsz) {
    const int pos = (int)(idx >> 4), i = (int)(idx & 15);
    const float ang = (float)pos * ROPE_INV[i];
    const double rev = (double)ang * 0.15915494309189533577;
    const float fr = (float)(rev - floor(rev));
    rope[idx * 2] = __builtin_amdgcn_cosf(fr);
    rope[idx * 2 + 1] = __builtin_amdgcn_sinf(fr);
  }
}

DI void phase_xn(const Ctx& c, int layer, const float* __restrict__ g) {
  const int lane = threadIdx.x & 63;
  const int gw = blockIdx.x * 4 + (threadIdx.x >> 6), nw = gridDim.x * 4;
  bf16_t* xn = c.wsp<bf16_t>(WS_X);
  for (int row = gw; row < NT; row += nw) {
    const float* x = c.xin_row(layer, row);
    f32x4 v[4];
    float ss = 0.f;
#pragma unroll
    for (int i = 0; i < 2; ++i) {
      v[2 * i] = *(const f32x4*)(x + i * 512 + lane * 8);
      v[2 * i + 1] = *(const f32x4*)(x + i * 512 + lane * 8 + 4);
      ss += v[2 * i][0] * v[2 * i][0] + v[2 * i][1] * v[2 * i][1] + v[2 * i][2] * v[2 * i][2] + v[2 * i][3] * v[2 * i][3];
      ss += v[2 * i + 1][0] * v[2 * i + 1][0] + v[2 * i + 1][1] * v[2 * i + 1][1] + v[2 * i + 1][2] * v[2 * i + 1][2] + v[2 * i + 1][3] * v[2 * i + 1][3];
    }
    ss = wave_sum(ss);
    const float rinv = rsqrtf(ss * (1.f / 1024.f) + EPS);
#pragma unroll
    for (int i = 0; i < 2; ++i) {
      f32x4 g0 = *(const f32x4*)(g + i * 512 + lane * 8), g1 = *(const f32x4*)(g + i * 512 + lane * 8 + 4);
      f32x4 a = v[2 * i] * g0 * rinv, b = v[2 * i + 1] * g1 * rinv;
      u32x4 o = {pk2(a[0], a[1]), pk2(a[2], a[3]), pk2(b[0], b[1]), pk2(b[2], b[3])};
      *(u32x4*)(xn + (size_t)row * DM + i * 512 + lane * 8) = o;
    }
  }
}

DI void conv_cache(const float* __restrict__ ck, const float* __restrict__ cv, bf16_t* __restrict__ Ks, bf16_t* __restrict__ Vts,
                   float* __restrict__ ok, float* __restrict__ ov, int L, int H, int Dh) {
  const long gtid = (long)blockIdx.x * 256 + threadIdx.x, gsz = (long)gridDim.x * 256;
  const int W = H * Dh, W8 = W / 8, LT = L + 64;
  const long nk = (long)SBATCH * L * W8;
  for (long idx = gtid; idx < nk; idx += gsz) {
    const int c8 = (int)(idx % W8); const long br = idx / W8; const int row = (int)(br % L), b = (int)(br / L);
    const float* p = ck + ((size_t)b * L + row) * W + c8 * 8;
    f32x4 a = *(const f32x4*)p, d = *(const f32x4*)(p + 4);
    u32x4 o = {pk2(a[0], a[1]), pk2(a[2], a[3]), pk2(d[0], d[1]), pk2(d[2], d[3])};
    *(u32x4*)(Ks + ((size_t)b * LT + row) * W + c8 * 8) = o;
    if (row >= 64) {
      float* q = ok + ((size_t)b * L + row - 64) * W + c8 * 8;
      *(f32x4*)q = a; *(f32x4*)(q + 4) = d;
      const float* pv = cv + ((size_t)b * L + row) * W + c8 * 8;
      float* qv = ov + ((size_t)b * L + row - 64) * W + c8 * 8;
      *(f32x4*)qv = *(const f32x4*)pv; *(f32x4*)(qv + 4) = *(const f32x4*)(pv + 4);
    }
  }
  const int KG = L / 8;
  const long nv = (long)SBATCH * H * KG * Dh;
  for (long idx = gtid; idx < nv; idx += gsz) {
    const int dv = (int)(idx % Dh); long rest = idx / Dh; const int kg = (int)(rest % KG); rest /= KG; const int hh = (int)(rest % H), b = (int)(rest / H);
    const float* p = cv + ((size_t)b * L + kg * 8) * W + hh * Dh + dv;
    u32x4 o = {pk2(p[0], p[(size_t)W]), pk2(p[(size_t)2 * W], p[(size_t)3 * W]), pk2(p[(size_t)4 * W], p[(size_t)5 * W]), pk2(p[(size_t)6 * W], p[(size_t)7 * W])};
    *(u32x4*)(Vts + (((size_t)b * H + hh) * Dh + dv) * LT + kg * 8) = o;
  }
}
DI void conv_cache_c(const Ctx& c) {
  const long gtid = (long)blockIdx.x * 256 + threadIdx.x, gsz = (long)gridDim.x * 256;
  const float* ckv = c.in[6]; const float* ckr = c.in[7];
  bf16_t* CKVs = c.wsp<bf16_t>(WS_CCKVS); bf16_t* KRs = c.wsp<bf16_t>(WS_CKRS);
  const long n1 = (long)SBATCH * PAST * 32;
  for (long idx = gtid; idx < n1; idx += gsz) {
    const int c8 = (int)(idx & 31); const long br = idx >> 5; const int row = (int)(br % PAST), b = (int)(br / PAST);
    const float* p = ckv + ((size_t)b * PAST + row) * 256 + c8 * 8;
    f32x4 a = *(const f32x4*)p, d = *(const f32x4*)(p + 4);
    u32x4 o = {pk2(a[0], a[1]), pk2(a[2], a[3]), pk2(d[0], d[1]), pk2(d[2], d[3])};
    *(u32x4*)(CKVs + ((size_t)b * CKEYS + row) * 256 + c8 * 8) = o;
  }
  const long n2 = (long)SBATCH * PAST * 4;
  for (long idx = gtid; idx < n2; idx += gsz) {
    const int c8 = (int)(idx & 3); const long br = idx >> 2; const int row = (int)(br % PAST), b = (int)(br / PAST);
    const float* p = ckr + ((size_t)b * PAST + row) * 32 + c8 * 8;
    f32x4 a = *(const f32x4*)p, d = *(const f32x4*)(p + 4);
    u32x4 o = {pk2(a[0], a[1]), pk2(a[2], a[3]), pk2(d[0], d[1]), pk2(d[2], d[3])};
    *(u32x4*)(KRs + ((size_t)b * CKEYS + row) * 32 + c8 * 8) = o;
  }
}

DI void phase_gemm_a_in(const Ctx& c, unsigned char* lds, int j) {
  const bf16_t* XN = c.wsp<bf16_t>(WS_X);
  const bf16_t* Wt = c.wsp<bf16_t>(WS_WAIN) + (size_t)j * 4096 * 1024;
  const float* qg = c.in[10] + j * 128; const float* kg = c.in[11] + j * 128;
  bf16_t* Q = c.wsp<bf16_t>(WS_AQ); bf16_t* Kp = c.wsp<bf16_t>(WS_AKP); bf16_t* Ks = c.wsp<bf16_t>(WS_AKS);
  bf16_t* Vtp = c.wsp<bf16_t>(WS_AVTP); bf16_t* Vts = c.wsp<bf16_t>(WS_AVTS); bf16_t* SG = c.wsp<bf16_t>(WS_SG);
  const int t = threadIdx.x;
  const int ntiles = (NT / 128) * 32;
  for (int tile = blockIdx.x; tile < ntiles; tile += gridDim.x) {
    const int mt = tile >> 5, nt = tile & 31, m0 = mt * 128, n0 = nt * 128;
    gemm_tile_to_lds(lds, XN + (size_t)m0 * DM, DM, Wt + (size_t)n0 * DM, DM, DM);
    const float* Cs = (const float*)lds;
    const int type = nt >> 3, head = nt & 7;
    const int row = t >> 1, half = t & 1, grow = m0 + row;
    const float* rp = Cs + row * C_STR + half * 64;
    const bool prompt = m0 < NP;
    if (type == 0) {
      float ss = row_sumsq(rp, 16); ss += __shfl_xor(ss, 1);
      const float rinv = rsqrtf(ss * (1.f / 128.f) + EPS);
      norm_store64(rp, qg + half * 64, rinv * QS_A, Q + (size_t)grow * DM + head * 128 + half * 64, 0.f, nullptr);
    } else if (type == 1) {
      float ss = row_sumsq(rp, 16); ss += __shfl_xor(ss, 1);
      const float rinv = rsqrtf(ss * (1.f / 128.f) + EPS);
      bf16_t* dst; float* fdst = nullptr;
      if (prompt) {
        const int b = grow >> 12, s = grow & 4095;
        dst = Kp + (size_t)grow * DM + head * 128 + half * 64;
        if (s >= SEQ - 512) fdst = c.out + O_AKP + ((((size_t)j * PB + b) * 512 + (s - (SEQ - 512))) * 8 + head) * 128 + half * 64;
      } else {
        const int sr = grow - NP, b = sr >> 6, tt = sr & 63;
        dst = Ks + ((size_t)b * 576 + 512 + tt) * DM + head * 128 + half * 64;
        fdst = c.out + O_AKS + ((((size_t)j * SBATCH + b) * 512 + 448 + tt) * 8 + head) * 128 + half * 64;
      }
      norm_store64(rp, kg + half * 64, rinv, dst, rinv, fdst);
    } else if (type == 2) {
      float* fdst = nullptr;
      if (prompt) {
        const int b = grow >> 12, s = grow & 4095;
        if (s >= SEQ - 512) fdst = c.out + O_AVP + ((((size_t)j * PB + b) * 512 + (s - (SEQ - 512))) * 8 + head) * 128 + half * 64;
      } else {
        const int sr = grow - NP, b = sr >> 6, tt = sr & 63;
        fdst = c.out + O_AVS + ((((size_t)j * SBATCH + b) * 512 + 448 + tt) * 8 + head) * 128 + half * 64;
      }
      if (fdst) raw_store64_f32(rp, fdst);
      const int col = t & 127, rh = t >> 7;
      bf16_t* dst;
      if (prompt) { const int b = m0 >> 12, s0 = (m0 & 4095) + rh * 64; dst = Vtp + (((size_t)b * 8 + head) * 128 + col) * SEQ + s0; }
      else { const int b = ((m0 - NP) >> 6) + rh; dst = Vts + (((size_t)b * 8 + head) * 128 + col) * 576 + 512; }
      tr_store64(Cs, col, rh, dst);
    } else {
      silu_store64(rp, SG + (size_t)grow * DM + head * 128 + half * 64);
    }
  }
}

DI void phase_gemm_b_in(const Ctx& c, unsigned char* lds) {
  const bf16_t* XN = c.wsp<bf16_t>(WS_X);
  const bf16_t* Wt = c.wsp<bf16_t>(WS_WBIN);
  const float* qg = c.in[16]; const float* kg = c.in[17];
  bf16_t* Q = c.wsp<bf16_t>(WS_BQ); bf16_t* Kp = c.wsp<bf16_t>(WS_BKP); bf16_t* Ks = c.wsp<bf16_t>(WS_BKS);
  bf16_t* Vtp = c.wsp<bf16_t>(WS_BVTP); bf16_t* Vts = c.wsp<bf16_t>(WS_BVTS); bf16_t* SG = c.wsp<bf16_t>(WS_SG);
  const int t = threadIdx.x;
  const int ntiles = (NT / 128) * 20;
  for (int tile = blockIdx.x; tile < ntiles; tile += gridDim.x) {
    const int mt = tile / 20, nt = tile % 20, m0 = mt * 128, n0 = nt * 128;
    gemm_tile_to_lds(lds, XN + (size_t)m0 * DM, DM, Wt + (size_t)n0 * DM, DM, DM);
    const float* Cs = (const float*)lds;
    const int row = t >> 1, half = t & 1, grow = m0 + row;
    const float* rp = Cs + row * C_STR + half * 64;
    const bool prompt = m0 < NP;
    if (nt < 8) {
      const int head = nt * 2 + half;
      const float ss = row_sumsq(rp, 16);
      const float rinv = rsqrtf(ss * (1.f / 64.f) + EPS);
      norm_store64(rp, qg, rinv * QS_B, Q + (size_t)grow * DM + head * 64, 0.f, nullptr);
    } else if (nt < 10) {
      const int hk = (nt - 8) * 2 + half;
      const float ss = row_sumsq(rp, 16);
      const float rinv = rsqrtf(ss * (1.f / 64.f) + EPS);
      bf16_t* dst; float* fdst = nullptr;
      if (prompt) {
        const int b = grow >> 12, s = grow & 4095;
        dst = Kp + (size_t)grow * 256 + hk * 64;
        if (s >= SEQ - 128) fdst = c.out + O_BKP + (((size_t)b * 128 + (s - (SEQ - 128))) * 4 + hk) * 64;
      } else {
        const int sr = grow - NP, b = sr >> 6, tt = sr & 63;
        dst = Ks + ((size_t)b * 192 + 128 + tt) * 256 + hk * 64;
        fdst = c.out + O_BKS + (((size_t)b * 128 + 64 + tt) * 4 + hk) * 64;
      }
      norm_store64(rp, kg, rinv, dst, rinv, fdst);
    } else if (nt < 12) {
      const int hk = (nt - 10) * 2 + half;
      float* fdst = nullptr;
      if (prompt) {
        const int b = grow >> 12, s = grow & 4095;
        if (s >= SEQ - 128) fdst = c.out + O_BVP + (((size_t)b * 128 + (s - (SEQ - 128))) * 4 + hk) * 64;
      } else {
        const int sr = grow - NP, b = sr >> 6, tt = sr & 63;
        fdst = c.out + O_BVS + (((size_t)b * 128 + 64 + tt) * 4 + hk) * 64;
      }
      if (fdst) raw_store64_f32(rp, fdst);
      const int col = t & 127, rh = t >> 7, hk2 = (nt - 10) * 2 + (col >> 6), dv = col & 63;
      bf16_t* dst;
      if (prompt) { const int b = m0 >> 12, s0 = (m0 & 4095) + rh * 64; dst = Vtp + (((size_t)b * 4 + hk2) * 64 + dv) * SEQ + s0; }
      else { const int b = ((m0 - NP) >> 6) + rh; dst = Vts + (((size_t)b * 4 + hk2) * 64 + dv) * 192 + 128; }
      tr_store64(Cs, col, rh, dst);
    } else {
      silu_store64(rp, SG + (size_t)grow * DM + (nt - 12) * 128 + half * 64);
    }
  }
}

DI void phase_gemm_c_in(const Ctx& c, unsigned char* lds) {
  const bf16_t* XN = c.wsp<bf16_t>(WS_X);
  const bf16_t* Wt = c.wsp<bf16_t>(WS_WCIN);
  bf16_t* SG = c.wsp<bf16_t>(WS_SG); float* Z = c.wsp<float>(WS_CZ);
  const int t = threadIdx.x;
  const int ntiles = (NT / 128) * 15;
  for (int tile = blockIdx.x; tile < ntiles; tile += gridDim.x) {
    const int mt = tile / 15, nt = tile % 15, m0 = mt * 128, n0 = nt * 128;
    gemm_tile_to_lds(lds, XN + (size_t)m0 * DM, DM, Wt + (size_t)n0 * DM, DM, DM);
    const float* Cs = (const float*)lds;
    const int row = t >> 1, half = t & 1, grow = m0 + row;
    const float* rp = Cs + row * C_STR + half * 64;
    if (nt < 8) {
      silu_store64(rp, SG + (size_t)grow * DM + nt * 128 + half * 64);
    } else {
      const int zc0 = (nt - 8) * 128 + half * 64;
#pragma unroll
      for (int jj = 0; jj < 16; ++jj) {
        if (zc0 + 4 * jj < 800) *(f32x4*)(Z + (size_t)grow * 800 + zc0 + 4 * jj) = *(const f32x4*)(rp + 4 * jj);
      }
    }
  }
}

DI void phase_c_norm(const Ctx& c) {
  const int lane = threadIdx.x & 63;
  const int gw = blockIdx.x * 4 + (threadIdx.x >> 6), nw = gridDim.x * 4;
  const float* Z = c.wsp<float>(WS_CZ);
  bf16_t* QA = c.wsp<bf16_t>(WS_CQA);
  bf16_t* CKVp = c.wsp<bf16_t>(WS_CCKVP); bf16_t* CKVs = c.wsp<bf16_t>(WS_CCKVS);
  bf16_t* KRp = c.wsp<bf16_t>(WS_CKRP); bf16_t* KRs = c.wsp<bf16_t>(WS_CKRS);
  const float* qag = c.in[22]; const float* kvag = c.in[24]; const float* ckg = c.in[27];
  const float* rope = c.wsp<float>(WS_ROPE);
  for (int row = gw; row < NT; row += nw) {
    const float* z = Z + (size_t)row * 800;
    const bool prompt = row < NP;
    int b, s, pos;
    if (prompt) { b = row >> 12; s = row & 4095; pos = s; } else { b = (row - NP) >> 6; s = (row - NP) & 63; pos = PAST + s; }
    {
      f32x4 a = *(const f32x4*)(z + lane * 8), d = *(const f32x4*)(z + lane * 8 + 4);
      float ss = a[0] * a[0] + a[1] * a[1] + a[2] * a[2] + a[3] * a[3] + d[0] * d[0] + d[1] * d[1] + d[2] * d[2] + d[3] * d[3];
      ss = wave_sum(ss);
      const float rinv = rsqrtf(ss * (1.f / 512.f) + EPS);
      f32x4 g0 = *(const f32x4*)(qag + lane * 8), g1 = *(const f32x4*)(qag + lane * 8 + 4);
      a = a * g0 * rinv; d = d * g1 * rinv;
      u32x4 o = {pk2(a[0], a[1]), pk2(a[2], a[3]), pk2(d[0], d[1]), pk2(d[2], d[3])};
      *(u32x4*)(QA + (size_t)row * 512 + lane * 8) = o;
    }
    {
      f32x4 a = *(const f32x4*)(z + 512 + lane * 4);
      float ss = a[0] * a[0] + a[1] * a[1] + a[2] * a[2] + a[3] * a[3];
      ss = wave_sum(ss);
      const float rinv = rsqrtf(ss * (1.f / 256.f) + EPS);
      f32x4 g0 = *(const f32x4*)(kvag + lane * 4);
      a = a * g0 * rinv;
      u32x2 o = {pk2(a[0], a[1]), pk2(a[2], a[3])};
      if (prompt) {
        *(f32x4*)(c.out + O_CKVP + (size_t)row * 256 + lane * 4) = a;
        *(u32x2*)(CKVp + (size_t)row * 256 + lane * 4) = o;
      } else {
        *(f32x4*)(c.out + O_CKVS + ((size_t)b * 64 + s) * 256 + lane * 4) = a;
        *(u32x2*)(CKVs + ((size_t)b * CKEYS + PAST + s) * 256 + lane * 4) = o;
      }
    }
    {
      float v = lane < 32 ? z[768 + lane] : 0.f;
      float ss = wave_sum(v * v);
      const float rinv = rsqrtf(ss * (1.f / 32.f) + EPS);
      const float xn = v * rinv * ckg[64 + (lane & 31)];
      const float other = __shfl_xor(xn, 16);
      const int i = lane & 15;
      const float cs = rope[((size_t)pos * 16 + i) * 2], sn = rope[((size_t)pos * 16 + i) * 2 + 1];
      const float o = (lane & 16) ? (other * sn + xn * cs) : (xn * cs - other * sn);
      if (lane < 32) {
        const unsigned ob = pk2(o, 0.f) & 0xffffu;
        if (prompt) {
          c.out[O_CKRP + (size_t)row * 32 + lane] = o;
          KRp[(size_t)row * 32 + lane] = (bf16_t)ob;
        } else {
          c.out[O_CKRS + ((size_t)b * 64 + s) * 32 + lane] = o;
          KRs[((size_t)b * CKEYS + PAST + s) * 32 + lane] = (bf16_t)ob;
        }
      }
    }
  }
}

DI void c_q_tile(const Ctx& c, unsigned char* lds, int mt, int nt) {
  const bf16_t* QA = c.wsp<bf16_t>(WS_CQA);
  const bf16_t* Wt = c.wsp<bf16_t>(WS_WCQB);
  bf16_t* Qc = c.wsp<bf16_t>(WS_CQ);
  const float* cqg = c.in[26];
  const float* rope = c.wsp<float>(WS_ROPE);
  const int t = threadIdx.x;
  const int m0 = mt * 128, n0 = nt * 128;
  gemm_tile_to_lds(lds, QA + (size_t)m0 * 512, 512, Wt + (size_t)n0 * 512, 512, 512);
  const float* Cs = (const float*)lds;
  const int row = t >> 1, half = t & 1, grow = m0 + row;
  const float* rp = Cs + row * C_STR + half * 64;
  if (nt < 8) {
    const int head = nt * 2 + half;
    const float ss = row_sumsq(rp, 16);
    const float rinv = rsqrtf(ss * (1.f / 64.f) + EPS);
    norm_store64(rp, cqg, rinv * QS_C, Qc + (size_t)grow * 1536 + head * 96, 0.f, nullptr);
  } else {
    const int pos = grow < NP ? (grow & 4095) : PAST + ((grow - NP) & 63);
    const float* rt = rope + (size_t)pos * 32;
#pragma unroll
    for (int sub = 0; sub < 2; ++sub) {
      const int head = (nt - 8) * 4 + half * 2 + sub;
      const float* xp = rp + sub * 32;
      const float ss = row_sumsq(xp, 8);
      const float sc = rsqrtf(ss * (1.f / 32.f) + EPS);
      bf16_t* dst = Qc + (size_t)grow * 1536 + head * 96 + 64;
#pragma unroll
      for (int q4 = 0; q4 < 4; ++q4) {
        f32x4 x1 = *(const f32x4*)(xp + 4 * q4), x2 = *(const f32x4*)(xp + 16 + 4 * q4);
        f32x4 g1 = *(const f32x4*)(cqg + 64 + 4 * q4), g2 = *(const f32x4*)(cqg + 80 + 4 * q4);
        x1 = x1 * g1 * sc; x2 = x2 * g2 * sc;
        f32x4 cs01 = *(const f32x4*)(rt + 8 * q4), cs23 = *(const f32x4*)(rt + 8 * q4 + 4);
        float o1[4], o2[4];
        o1[0] = x1[0] * cs01[0] - x2[0] * cs01[1]; o2[0] = x1[0] * cs01[1] + x2[0] * cs01[0];
        o1[1] = x1[1] * cs01[2] - x2[1] * cs01[3]; o2[1] = x1[1] * cs01[3] + x2[1] * cs01[2];
        o1[2] = x1[2] * cs23[0] - x2[2] * cs23[1]; o2[2] = x1[2] * cs23[1] + x2[2] * cs23[0];
        o1[3] = x1[3] * cs23[2] - x2[3] * cs23[3]; o2[3] = x1[3] * cs23[3] + x2[3] * cs23[2];
        u32x2 a = {pk2(o1[0] * QS_C, o1[1] * QS_C), pk2(o1[2] * QS_C, o1[3] * QS_C)};
        u32x2 d = {pk2(o2[0] * QS_C, o2[1] * QS_C), pk2(o2[2] * QS_C, o2[3] * QS_C)};
        *(u32x2*)(dst + 4 * q4) = a;
        *(u32x2*)(dst + 16 + 4 * q4) = d;
      }
    }
  }
}
DI void c_kv_tile(const Ctx& c, unsigned char* lds, const bf16_t* A, bf16_t* Kn, bf16_t* Vt, int rows_per_b, int mt, int nt) {
  const bf16_t* Wt = c.wsp<bf16_t>(WS_WCKVB);
  const float* ckg = c.in[27];
  const int t = threadIdx.x;
  const int m0 = mt * 128, n0 = nt * 128;
  gemm_tile_to_lds(lds, A + (size_t)m0 * 256, 256, Wt + (size_t)n0 * 256, 256, 256);
  const float* Cs = (const float*)lds;
  if (nt < 8) {
    const int row = t >> 1, half = t & 1, grow = m0 + row;
    const float* rp = Cs + row * C_STR + half * 64;
    const int head = nt * 2 + half;
    const int b = grow / rows_per_b, s = grow - b * rows_per_b;
    const float ss = row_sumsq(rp, 16);
    const float rinv = rsqrtf(ss * (1.f / 64.f) + EPS);
    norm_store64(rp, ckg, rinv, Kn + (((size_t)b * 16 + head) * rows_per_b + s) * 64, 0.f, nullptr);
  } else {
    const int col = t & 127, rh = t >> 7, head = (nt - 8) * 2 + (col >> 6), dv = col & 63;
    const int rr = m0 + rh * 64, b = rr / rows_per_b, s0 = rr - b * rows_per_b;
    tr_store64(Cs, col, rh, Vt + (((size_t)b * 16 + head) * 64 + dv) * rows_per_b + s0);
  }
}
DI void phase_c_proj(const Ctx& c, unsigned char* lds, int round) {
  const int nq = round == 0 ? (NT / 128) * 12 : 0;
  const int nkp = round == 0 ? (NP / 128) * 16 : 0;
  const int nks = (CROUND_B * CKEYS / 128) * 16;
  bf16_t* Knp = (bf16_t*)(c.out + O_SCR_KNP); bf16_t* Vtp = (bf16_t*)(c.out + O_SCR_VTP);
  const int total = nq + nkp + nks;
  for (int tile = blockIdx.x; tile < total; tile += gridDim.x) {
    if (tile < nq) c_q_tile(c, lds, tile / 12, tile % 12);
    else if (tile < nq + nkp) { const int u = tile - nq; c_kv_tile(c, lds, c.wsp<bf16_t>(WS_CCKVP), Knp, Vtp, SEQ, u >> 4, u & 15); }
    else { const int u = tile - nq - nkp;
      c_kv_tile(c, lds, c.wsp<bf16_t>(WS_CCKVS) + (size_t)round * CROUND_B * CKEYS * 256, c.wsp<bf16_t>(WS_CKNS), c.wsp<bf16_t>(WS_CVTS), CKEYS, u >> 4, u & 15); }
  }
}

DI void phase_gemm_out(const Ctx& c, unsigned char* lds, int layer, const bf16_t* Wt) {
  const bf16_t* OG = c.wsp<bf16_t>(WS_SG);
  const int t = threadIdx.x;
  const int ntiles = (NT / 128) * 8;
  for (int tile = blockIdx.x; tile < ntiles; tile += gridDim.x) {
    const int mt = tile >> 3, nt = tile & 7, m0 = mt * 128, n0 = nt * 128;
    gemm_tile_to_lds(lds, OG + (size_t)m0 * DM, DM, Wt + (size_t)n0 * DM, DM, DM);
    const float* Cs = (const float*)lds;
    const int row = t >> 1, half = t & 1, grow = m0 + row;
    const float* rp = Cs + row * C_STR + half * 64;
    const float* xo = c.xin_row(layer, grow) + n0 + half * 64;
    float* xn = c.out + (size_t)grow * DM + n0 + half * 64;
#pragma unroll
    for (int jj = 0; jj < 16; ++jj) {
      f32x4 a = *(const f32x4*)(xo + 4 * jj);
      *(f32x4*)(xn + 4 * jj) = a + *(const f32x4*)(rp + 4 * jj);
    }
  }
}

struct AttnItem {
  const bf16_t* k1; long ks1;
  const bf16_t* k2; long ks2;
  const bf16_t* vt; long vts;
  int t0, t1;
  const bf16_t* qrow;
  long qs;
  bf16_t* og;
  int cw;
  int qi0;
  float bslope;
  float m0, l0;
};

template <int DQK, int DV, int BIAS, int BAND, int KCH1>
DI void attn_item(unsigned char* lds, const AttnItem& it) {
  constexpr int KSTR = DQK * 2 + 16, VSTR = 136;
  constexpr int KBYTES = 64 * KSTR, VBYTES = DV * VSTR;
  constexpr int KCH = DQK / 8, NKL = 64 * KCH / 256, NVL = DV * 8 / 256;
  constexpr int NKS = DQK / 16, NDB = DV / 32;
  static_assert(2 * KBYTES + 2 * VBYTES + 1040 <= LDS_BYTES, "attn lds");
  const int t = threadIdx.x, lane = t & 63, r = lane & 31, h = lane >> 5;
  unsigned char* Kl = lds; unsigned char* Vl = lds + 2 * KBYTES;
  const float* tab = (const float*)(lds + 2 * KBYTES + 2 * VBYTES);
  bf16x8 qf[NKS];
  {
    const bf16_t* qp = it.qrow + (long)r * it.qs + h * 8;
#pragma unroll
    for (int ks = 0; ks < NKS; ++ks) qf[ks] = *(const bf16x8*)(qp + ks * 16);
  }
  f32x16 o[NDB];
#pragma unroll
  for (int d = 0; d < NDB; ++d) o[d] = f32x16{};
  float m = it.m0, l = it.l0;
  u32x4 kr[NKL]; u32x4 vr[NVL];
  auto gload = [&](int tile) {
#pragma unroll
    for (int i = 0; i < NKL; ++i) {
      const int e = t + 256 * i, row = e / KCH, ch = e - row * KCH;
      const long key = (long)tile * 64 + row;
      const bf16_t* src = (ch < KCH1) ? it.k1 + key * it.ks1 + ch * 8 : it.k2 + key * it.ks2 + (ch - KCH1) * 8;
      kr[i] = *(const u32x4*)src;
    }
#pragma unroll
    for (int i = 0; i < NVL; ++i) {
      const int e = t + 256 * i, dv = e >> 3, ch = e & 7;
      vr[i] = *(const u32x4*)(it.vt + (long)dv * it.vts + (long)tile * 64 + ch * 8);
    }
  };
  auto lwrite = [&](int buf) {
#pragma unroll
    for (int i = 0; i < NKL; ++i) {
      const int e = t + 256 * i, row = e / KCH, ch = e - row * KCH;
      *(u32x4*)(Kl + buf * KBYTES + row * KSTR + ch * 16) = kr[i];
    }
#pragma unroll
    for (int i = 0; i < NVL; ++i) {
      const int e = t + 256 * i, dv = e >> 3, ch = e & 7;
      unsigned char* d = Vl + buf * VBYTES + dv * VSTR + ch * 16;
      *(u32x2*)d = (u32x2){vr[i][0], vr[i][1]};
      *(u32x2*)(d + 8) = (u32x2){vr[i][2], vr[i][3]};
    }
  };
  gload(it.t0);
  __syncthreads();
  lwrite(0);
  __syncthreads();
  const int ntile = it.t1 - it.t0 + 1;
  for (int jt = 0; jt < ntile; ++jt) {
    const int buf = jt & 1, tile = it.t0 + jt;
    if (jt + 1 < ntile) gload(tile + 1);
    const bool active = (tile <= it.cw) && (tile >= it.cw - (BAND - 1));
    if (active) {
      f32x16 s0, s1;
      const int dt = it.cw - tile;
      const int dbase = dt * 64 + it.qi0 + r - 4 * h;
      if (BIAS == 1) {
        if (dt >= 3) { const float cb = tab[256];
#pragma unroll
          for (int i = 0; i < 16; ++i) { s0[i] = cb; s1[i] = cb; }
        } else {
#pragma unroll
          for (int i = 0; i < 16; ++i) {
            const int d0 = dbase - ((i & 3) + 8 * (i >> 2));
            s0[i] = tab[min(max(d0, -128), 128) + 128];
            s1[i] = tab[min(max(d0 - 32, -128), 128) + 128];
          }
        }
      } else if (BIAS == 2) {
#pragma unroll
        for (int i = 0; i < 16; ++i) {
          const int d0 = dbase - ((i & 3) + 8 * (i >> 2));
          s0[i] = -it.bslope * fabsf((float)d0);
          s1[i] = -it.bslope * fabsf((float)(d0 - 32));
        }
      } else {
#pragma unroll
        for (int i = 0; i < 16; ++i) { s0[i] = 0.f; s1[i] = 0.f; }
      }
      const unsigned char* kb = Kl + buf * KBYTES + r * KSTR + h * 16;
#pragma unroll
      for (int ks = 0; ks < NKS; ++ks) {
        bf16x8 k0 = *(const bf16x8*)(kb + ks * 32);
        bf16x8 k1 = *(const bf16x8*)(kb + 32 * KSTR + ks * 32);
        s0 = MFMA(k0, qf[ks], s0);
        s1 = MFMA(k1, qf[ks], s1);
      }
      float mx = s0[0];
#pragma unroll
      for (int i = 1; i < 16; ++i) mx = fmaxf(mx, s0[i]);
#pragma unroll
      for (int i = 0; i < 16; ++i) mx = fmaxf(mx, s1[i]);
      mx = fmaxf(mx, __shfl_xor(mx, 32));
      const float mn = fmaxf(m, mx);
      const float alpha = fast_exp2(m - mn);
      m = mn;
      float rs = 0.f;
#pragma unroll
      for (int i = 0; i < 16; ++i) { s0[i] = fast_exp2(s0[i] - mn); s1[i] = fast_exp2(s1[i] - mn); rs += s0[i] + s1[i]; }
      rs += __shfl_xor(rs, 32);
      l = l * alpha + rs;
#pragma unroll
      for (int d = 0; d < NDB; ++d)
#pragma unroll
        for (int i = 0; i < 16; ++i) o[d][i] *= alpha;
      bf16x8 pf[4];
      {
        u32x4 a = {pk2(s0[0], s0[1]), pk2(s0[2], s0[3]), pk2(s0[4], s0[5]), pk2(s0[6], s0[7])};
        u32x4 b = {pk2(s0[8], s0[9]), pk2(s0[10], s0[11]), pk2(s0[12], s0[13]), pk2(s0[14], s0[15])};
        u32x4 cc = {pk2(s1[0], s1[1]), pk2(s1[2], s1[3]), pk2(s1[4], s1[5]), pk2(s1[6], s1[7])};
        u32x4 dd = {pk2(s1[8], s1[9]), pk2(s1[10], s1[11]), pk2(s1[12], s1[13]), pk2(s1[14], s1[15])};
        pf[0] = __builtin_bit_cast(bf16x8, a); pf[1] = __builtin_bit_cast(bf16x8, b);
        pf[2] = __builtin_bit_cast(bf16x8, cc); pf[3] = __builtin_bit_cast(bf16x8, dd);
      }
      const unsigned char* vb = Vl + buf * VBYTES + r * VSTR + h * 8;
#pragma unroll
      for (int d = 0; d < NDB; ++d) {
#pragma unroll
        for (int kk = 0; kk < 4; ++kk) {
          const unsigned char* p = vb + d * 32 * VSTR + kk * 32;
          s16x4 lo = *(const s16x4*)p, hi = *(const s16x4*)(p + 16);
          bf16x8 vf = {lo[0], lo[1], lo[2], lo[3], hi[0], hi[1], hi[2], hi[3]};
          o[d] = MFMA(vf, pf[kk], o[d]);
        }
      }
    }
    if (jt + 1 < ntile) lwrite(buf ^ 1);
    __syncthreads();
  }
  if (it.cw >= 0) {
    const float linv = 1.f / l;
    bf16_t* op = it.og + (long)r * DM + 4 * h;
#pragma unroll
    for (int d = 0; d < NDB; ++d) {
#pragma unroll
      for (int g = 0; g < 4; ++g) {
        bf16_t* p = op + d * 32 + 8 * g;
        const u32x2 sg = *(const u32x2*)p;
        u32x2 ov = {pk2(o[d][4 * g] * linv * bf_lo(sg[0]), o[d][4 * g + 1] * linv * bf_hi(sg[0])),
                    pk2(o[d][4 * g + 2] * linv * bf_lo(sg[1]), o[d][4 * g + 3] * linv * bf_hi(sg[1]))};
        *(u32x2*)p = ov;
      }
    }
  }
}

DI void phase_attn_a(const Ctx& c, unsigned char* lds, int j) {
  const int w = __builtin_amdgcn_readfirstlane(threadIdx.x >> 6);
  const bf16_t* Q = c.wsp<bf16_t>(WS_AQ); const bf16_t* Kp = c.wsp<bf16_t>(WS_AKP); const bf16_t* Ks = c.wsp<bf16_t>(WS_AKS);
  const bf16_t* Vtp = c.wsp<bf16_t>(WS_AVTP); const bf16_t* Vts = c.wsp<bf16_t>(WS_AVTS); bf16_t* SG = c.wsp<bf16_t>(WS_SG);
  const float* rel = c.in[12] + (size_t)j * 8 * 257;
  float* tab = (float*)(lds + 2 * 64 * (128 * 2 + 16) + 2 * 128 * 136);
  const int nitems = 2048 + 256;
  for (int item = blockIdx.x; item < nitems; item += gridDim.x) {
    AttnItem it;
    int hh;
    if (item < 2048) {
      const int p = item >> 6, bh = item & 63, b = bh >> 3; hh = bh & 7;
      const int c0 = 2 * p;
      it.k1 = Kp + (size_t)b * SEQ * DM + hh * 128; it.ks1 = DM;
      it.vt = Vtp + ((size_t)b * 8 + hh) * 128 * SEQ; it.vts = SEQ;
      it.t0 = c0 - 8 > 0 ? c0 - 8 : 0; it.t1 = c0 + 1;
      it.cw = c0 + (w >> 1); it.qi0 = (w & 1) * 32;
      const size_t tok = (size_t)b * SEQ + it.cw * 64 + it.qi0;
      it.qrow = Q + tok * DM + hh * 128; it.og = SG + tok * DM + hh * 128;
    } else {
      const int u = item - 2048, b = u >> 3; hh = u & 7;
      it.k1 = Ks + (size_t)b * 576 * DM + hh * 128; it.ks1 = DM;
      it.vt = Vts + ((size_t)b * 8 + hh) * 128 * 576; it.vts = 576;
      it.t0 = 0; it.t1 = 8;
      it.cw = w < 2 ? 8 : -1000; it.qi0 = (w & 1) * 32;
      const size_t tok = (size_t)NP + b * 64 + it.qi0;
      it.qrow = Q + tok * DM + hh * 128; it.og = SG + tok * DM + hh * 128;
    }
    it.k2 = it.k1; it.ks2 = 0; it.qs = DM; it.bslope = 0.f; it.m0 = -1e30f; it.l0 = 0.f;
    __syncthreads();
    for (int i = threadIdx.x; i < 257; i += 256) tab[i] = rel[hh * 257 + i] * LOG2E;
    attn_item<128, 128, 1, 9, 16>(lds, it);
  }
}
DI void phase_attn_b(const Ctx& c, unsigned char* lds) {
  const int w = __builtin_amdgcn_readfirstlane(threadIdx.x >> 6);
  const bf16_t* Q = c.wsp<bf16_t>(WS_BQ); const bf16_t* Kp = c.wsp<bf16_t>(WS_BKP); const bf16_t* Ks = c.wsp<bf16_t>(WS_BKS);
  const bf16_t* Vtp = c.wsp<bf16_t>(WS_BVTP); const bf16_t* Vts = c.wsp<bf16_t>(WS_BVTS); bf16_t* SG = c.wsp<bf16_t>(WS_SG);
  const float* sinks = c.in[18];
  const int nitems = 4096 + 256;
  for (int item = blockIdx.x; item < nitems; item += gridDim.x) {
    AttnItem it;
    int head;
    if (item < 4096) {
      const int gp = item & 1, hk = (item >> 1) & 3, cc = (item >> 3) & 63, b = item >> 9;
      head = hk * 4 + gp * 2 + (w >> 1);
      it.k1 = Kp + (size_t)b * SEQ * 256 + hk * 64; it.ks1 = 256;
      it.vt = Vtp + ((size_t)b * 4 + hk) * 64 * SEQ; it.vts = SEQ;
      it.t0 = cc - 2 > 0 ? cc - 2 : 0; it.t1 = cc;
      it.cw = cc; it.qi0 = (w & 1) * 32;
      const size_t tok = (size_t)b * SEQ + cc * 64 + it.qi0;
      it.qrow = Q + tok * DM + head * 64; it.og = SG + tok * DM + head * 64;
    } else {
      const int u = item - 4096, gp = u & 1, hk = (u >> 1) & 3, b = u >> 3;
      head = hk * 4 + gp * 2 + (w >> 1);
      it.k1 = Ks + (size_t)b * 192 * 256 + hk * 64; it.ks1 = 256;
      it.vt = Vts + ((size_t)b * 4 + hk) * 64 * 192; it.vts = 192;
      it.t0 = 0; it.t1 = 2;
      it.cw = 2; it.qi0 = (w & 1) * 32;
      const size_t tok = (size_t)NP + b * 64 + it.qi0;
      it.qrow = Q + tok * DM + head * 64; it.og = SG + tok * DM + head * 64;
    }
    it.k2 = it.k1; it.ks2 = 0; it.qs = DM;
    it.bslope = exp2f(-0.5f * (float)(head + 1)) * LOG2E;
    it.m0 = sinks[head] * LOG2E; it.l0 = 1.f;
    attn_item<64, 64, 2, 3, 8>(lds, it);
  }
}
DI void phase_attn_c(const Ctx& c, unsigned char* lds, int round) {
  const int w = __builtin_amdgcn_readfirstlane(threadIdx.x >> 6);
  const bf16_t* Qc = c.wsp<bf16_t>(WS_CQ); bf16_t* SG = c.wsp<bf16_t>(WS_SG);
  const bf16_t* Knp = (const bf16_t*)(c.out + O_SCR_KNP); const bf16_t* Vtp = (const bf16_t*)(c.out + O_SCR_VTP);
  const bf16_t* KRp = c.wsp<bf16_t>(WS_CKRP); const bf16_t* KRs = c.wsp<bf16_t>(WS_CKRS);
  const bf16_t* Kns = c.wsp<bf16_t>(WS_CKNS); const bf16_t* Vts = c.wsp<bf16_t>(WS_CVTS);
  const int npr = round == 0 ? 4096 : 0;
  const int nitems = npr + CROUND_B * 16;
  for (int item = blockIdx.x; item < nitems; item += gridDim.x) {
    AttnItem it;
    if (item < npr) {
      const int p = 31 - (item >> 7), bh = item & 127, b = bh >> 4, hh = bh & 15;
      it.k1 = Knp + ((size_t)b * 16 + hh) * SEQ * 64; it.ks1 = 64;
      it.k2 = KRp + (size_t)b * SEQ * 32; it.ks2 = 32;
      it.vt = Vtp + ((size_t)b * 16 + hh) * 64 * SEQ; it.vts = SEQ;
      it.t0 = 0; it.t1 = 2 * p + 1;
      it.cw = 2 * p + (w >> 1); it.qi0 = (w & 1) * 32;
      const size_t tok = (size_t)b * SEQ + it.cw * 64 + it.qi0;
      it.qrow = Qc + tok * 1536 + hh * 96; it.og = SG + tok * DM + hh * 64;
    } else {
      const int u = item - npr, bl = u >> 4, hh = u & 15, b = round * CROUND_B + bl;
      it.k1 = Kns + ((size_t)bl * 16 + hh) * CKEYS * 64; it.ks1 = 64;
      it.k2 = KRs + (size_t)b * CKEYS * 32; it.ks2 = 32;
      it.vt = Vts + ((size_t)bl * 16 + hh) * 64 * CKEYS; it.vts = CKEYS;
      it.t0 = 0; it.t1 = 32;
      it.cw = w < 2 ? 32 : -1000; it.qi0 = (w & 1) * 32;
      const size_t tok = (size_t)NP + b * 64 + it.qi0;
      it.qrow = Qc + tok * 1536 + hh * 96; it.og = SG + tok * DM + hh * 64;
    }
    it.qs = 1536; it.bslope = 0.f; it.m0 = -1e30f; it.l0 = 0.f;
    attn_item<96, 64, 0, 100000, 8>(lds, it);
  }
}

constexpr int N_PHASES = 20;
__global__ void __launch_bounds__(256, 2) mega(Params P) {
  __shared__ __attribute__((aligned(16))) unsigned char lds[LDS_BYTES];
  Ctx c{P.in, P.out, P.ws};
  const int lo = P.ph_lo, hi = P.ph_hi;
#define IN(k) (lo <= (k) && (k) < hi)
#if MODE_COOP
#define SEAM(k) do { if (IN(k) && IN((k) + 1)) cg::this_grid().sync(); } while (0)
#else
#define SEAM(k) do { } while (0)
#endif
  if (IN(0)) { phase_prep(c); phase_xn(c, 0, c.in[8]);
               conv_cache(c.in[2], c.in[3], c.wsp<bf16_t>(WS_AKS), c.wsp<bf16_t>(WS_AVTS), c.out + O_AKS, c.out + O_AVS, 512, 8, 128); }
  SEAM(0);
  if (IN(1)) phase_gemm_a_in(c, lds, 0);
  SEAM(1);
  if (IN(2)) phase_attn_a(c, lds, 0);
  SEAM(2);
  if (IN(3)) phase_gemm_out(c, lds, 0, c.wsp<bf16_t>(WS_WAOUT));
  SEAM(3);
  if (IN(4)) { phase_xn(c, 1, c.in[14]);
               conv_cache(c.in[4], c.in[5], c.wsp<bf16_t>(WS_BKS), c.wsp<bf16_t>(WS_BVTS), c.out + O_BKS, c.out + O_BVS, 128, 4, 64); }
  SEAM(4);
  if (IN(5)) phase_gemm_b_in(c, lds);
  SEAM(5);
  if (IN(6)) phase_attn_b(c, lds);
  SEAM(6);
  if (IN(7)) phase_gemm_out(c, lds, 1, c.wsp<bf16_t>(WS_WBOUT));
  SEAM(7);
  if (IN(8)) phase_xn(c, 2, c.in[20]);
  SEAM(8);
  if (IN(9)) phase_gemm_c_in(c, lds);
  SEAM(9);
  if (IN(10)) { phase_c_norm(c); conv_cache_c(c); }
  SEAM(10);
  if (IN(11)) phase_c_proj(c, lds, 0);
  SEAM(11);
  if (IN(12)) phase_attn_c(c, lds, 0);
  SEAM(12);
  if (IN(13)) phase_c_proj(c, lds, 1);
  SEAM(13);
  if (IN(14)) phase_attn_c(c, lds, 1);
  SEAM(14);
  if (IN(15)) phase_gemm_out(c, lds, 2, c.wsp<bf16_t>(WS_WCOUT));
  SEAM(15);
  if (IN(16)) { phase_xn(c, 3, c.in[8] + 1024);
                conv_cache(c.in[2] + (size_t)SBATCH * 512 * 1024, c.in[3] + (size_t)SBATCH * 512 * 1024, c.wsp<bf16_t>(WS_AKS), c.wsp<bf16_t>(WS_AVTS),
                           c.out + O_AKS + 16777216, c.out + O_AVS + 16777216, 512, 8, 128); }
  SEAM(16);
  if (IN(17)) phase_gemm_a_in(c, lds, 1);
  SEAM(17);
  if (IN(18)) phase_attn_a(c, lds, 1);
  SEAM(18);
  if (IN(19)) phase_gemm_out(c, lds, 3, c.wsp<bf16_t>(WS_WAOUT) + (size_t)1024 * 1024);
#undef IN
#undef SEAM
}

extern "C" void kernel_launch(void* const* d_in, const int* in_sizes, int n_in, void* d_out, int out_size, void* d_ws, size_t ws_size, hipStream_t stream) {
  static int grid = 0;
  if (grid == 0) {
    if (n_in != 29 || (size_t)out_size != O_END || ws_size < WS_NEED) {
      fprintf(stderr, "kernel_launch: unexpected shapes: n_in %d out %d ws %zu (need %zu)\n", n_in, out_size, ws_size, (size_t)WS_NEED);
      grid = -1; return;
    }
    int dev = 0, cus = 0, per_cu = 0;
    hipGetDevice(&dev);
    hipDeviceGetAttribute(&cus, hipDeviceAttributeMultiprocessorCount, dev);
    hipOccupancyMaxActiveBlocksPerMultiprocessor(&per_cu, (const void*)mega, 256, 0);
    if (per_cu < 1) { fprintf(stderr, "kernel_launch: occupancy query returned %d\n", per_cu); grid = -1; return; }
    if (per_cu > 2) per_cu = 2;
    grid = cus * per_cu;
    fprintf(stderr, "kernel_launch: grid %d (%d CUs x %d)\n", grid, cus, per_cu);
  }
  if (grid < 0) return;
  Params p{};
  for (int i = 0; i < 29; ++i) p.in[i] = (const float*)d_in[i];
  p.out = (float*)d_out; p.ws = (unsigned char*)d_ws;
#if MODE_COOP
  p.ph_lo = 0; p.ph_hi = N_PHASES;
  void* args[] = {&p};
  hipError_t e = hipLaunchCooperativeKernel((const void*)mega, dim3(grid), dim3(256), args, 0, stream);
  if (e != hipSuccess) fprintf(stderr, "cooperative launch failed: %s (grid %d)\n", hipGetErrorString(e), grid);
#else
  for (int ph = 0; ph < 20; ++ph) {
    p.ph_lo = ph; p.ph_hi = ph + 1;
    hipLaunchKernelGGL(mega, dim3(grid), dim3(256), 0, stream, p);
  }
#endif
}
```

```cpp
#include <hip/hip_runtime.h>
#include <hip/hip_cooperative_groups.h>
#include <cstdio>
#include <cstdint>
namespace cg = cooperative_groups;

#ifndef MODE_COOP
#define MODE_COOP 1
#endif
#ifndef PROBE_DUP
#define PROBE_DUP 0u
#endif

#define DI __device__ __forceinline__
typedef unsigned short bf16_t;
using bf16x8 = __attribute__((ext_vector_type(8))) short;
using s16x4  = __attribute__((ext_vector_type(4))) short;
using f32x16 = __attribute__((ext_vector_type(16))) float;
using f32x4  = __attribute__((ext_vector_type(4))) float;
using u32x4  = __attribute__((ext_vector_type(4))) unsigned;
using u32x2  = __attribute__((ext_vector_type(2))) unsigned;
typedef __bf16 bf2_t __attribute__((ext_vector_type(2)));
typedef float f2_t __attribute__((ext_vector_type(2)));
#define MFMA(a, b, c) __builtin_amdgcn_mfma_f32_32x32x16_bf16((a), (b), (c), 0, 0, 0)

DI unsigned pk2(float lo, float hi) { f2_t v = {lo, hi}; return __builtin_bit_cast(unsigned, __builtin_convertvector(v, bf2_t)); }
DI float bf_lo(unsigned u) { return __uint_as_float(u << 16); }
DI float bf_hi(unsigned u) { return __uint_as_float(u & 0xffff0000u); }
DI int crow(int i, int h) { return (i & 3) + 8 * (i >> 2) + 4 * h; }
DI float wave_sum(float v) {
#pragma unroll
  for (int o = 32; o >= 1; o >>= 1) v += __shfl_xor(v, o);
  return v;
}
DI float fast_exp2(float x) { return __builtin_amdgcn_exp2f(x); }
DI float silu(float g) { return g / (1.f + __expf(-g)); }

#define XB_TMO      128
#define XB_XCNT(j)  (256  + 64 * (j))
#define XB_XSUB(j)  (1280 + 64 * (j))
#define XB_XGEN(j)  (2304 + 64 * (j))
#define XB_TOP      3328
#define XB_TOPGEN   3392
#define XCD_BAR_WORDS 3456
#define XB_SPIN_CAP (1u << 22)
#define LAS __attribute__((address_space(3)))
DI unsigned xb_ld(unsigned* p)              { return __hip_atomic_load(p, __ATOMIC_RELAXED, __HIP_MEMORY_SCOPE_AGENT); }
DI unsigned xb_add(unsigned* p, unsigned v) { return __hip_atomic_fetch_add(p, v, __ATOMIC_RELAXED, __HIP_MEMORY_SCOPE_AGENT); }
DI unsigned xb_xcc_id() { return (unsigned)__builtin_amdgcn_s_getreg((3 << 11) | 20) & 0xFu; }
#define XB_SPIN(cond, bar) do { unsigned _sp = 0; while (cond) { __builtin_amdgcn_s_sleep(1); \
    if ((++_sp & 255u) == 0u) { if (xb_ld(&(bar)[XB_TMO])) break; if (_sp > XB_SPIN_CAP) { atomicAdd(&(bar)[XB_TMO], 1u); break; } } } } while (0)
struct XcdBarrier { unsigned* bar; unsigned x; volatile LAS unsigned* st; };
DI XcdBarrier xcd_barrier_post(unsigned* bar, volatile LAS unsigned* st) {
  XcdBarrier b; b.bar = bar; b.x = xb_xcc_id(); b.st = st;
  if (threadIdx.x == 0) (void)xb_add(&bar[XB_XCNT(b.x)], 1u);
  return b;
}
DI void xcd_barrier_complete(unsigned* bar, unsigned x, unsigned& nloc, unsigned& nx) {
  const unsigned G = gridDim.x * gridDim.y * gridDim.z;
  unsigned sum, cnt, mine, sp = 0u;
  for (;;) {
    sum = 0u; cnt = 0u; mine = 0u;
#pragma unroll
    for (unsigned j = 0; j < 16; ++j) { const unsigned c = xb_ld(&bar[XB_XCNT(j)]); sum += c; cnt += (c > 0u) ? 1u : 0u; mine = (j == x) ? c : mine; }
    if (sum == G) break;
    __builtin_amdgcn_s_sleep(1);
    if ((++sp & 255u) == 0u) { if (xb_ld(&bar[XB_TMO])) break; if (sp > XB_SPIN_CAP) { atomicAdd(&bar[XB_TMO], 1u); break; } }
  }
  nloc = mine > 0u ? mine : 1u; nx = cnt > 0u ? cnt : 1u;
}
DI void xcd_barrier(const XcdBarrier& b) {
  asm volatile("s_waitcnt vmcnt(0)" ::: "memory");
  __syncthreads();
  if (threadIdx.x == 0) {
    unsigned* bar = b.bar;
    __builtin_amdgcn_s_waitcnt(0);
    unsigned nloc = b.st[0], nx = b.st[1];
    if (nloc == 0u) { xcd_barrier_complete(bar, b.x, nloc, nx); b.st[0] = nloc; b.st[1] = nx; }
    const unsigned old = xb_add(&bar[XB_XSUB(b.x)], 1u);
    const unsigned gen = old / nloc;
    if (old + 1u == (gen + 1u) * nloc) {
      __builtin_amdgcn_fence(__ATOMIC_RELEASE, "agent");
      asm volatile("s_waitcnt vmcnt(0)" ::: "memory");
      const unsigned og = xb_add(&bar[XB_TOP], 1u);
      const unsigned tg = og / nx;
      if (og + 1u == (tg + 1u) * nx) xb_add(&bar[XB_TOPGEN], 1u);
      else XB_SPIN(xb_ld(&bar[XB_TOPGEN]) == tg, bar);
      __builtin_amdgcn_fence(__ATOMIC_ACQUIRE, "agent");
      xb_add(&bar[XB_XGEN(b.x)], 1u);
      asm volatile("s_waitcnt vmcnt(0)" ::: "memory");
    } else {
      XB_SPIN(xb_ld(&bar[XB_XGEN(b.x)]) == gen, bar);
      __builtin_amdgcn_fence(__ATOMIC_ACQUIRE, "agent");
      asm volatile("s_waitcnt vmcnt(0)" ::: "memory");
    }
  }
  __syncthreads();
}

constexpr int DM = 1024;
constexpr int SEQ = 4096, PB = 8, SBATCH = 32, DSEQ = 64, PAST = 2048;
constexpr int NP = PB * SEQ;
constexpr int NS = SBATCH * DSEQ;
constexpr int NT = NP + NS;
constexpr float EPS = 1e-6f;
constexpr float LOG2E = 1.4426950408889634f;
constexpr float QS_A = 0.08838834764831845f * LOG2E;
constexpr float QS_B = 0.125f * LOG2E;
constexpr float QS_C = 0.10206207261596575f * LOG2E;
constexpr int CKEYS = PAST + DSEQ;
constexpr int CROUND_B = 16;

constexpr size_t O_Y      = 0;
constexpr size_t O_AKP    = O_Y + (size_t)NT * DM;
constexpr size_t O_AVP    = O_AKP + 8388608;
constexpr size_t O_BKP    = O_AVP + 8388608;
constexpr size_t O_BVP    = O_BKP + 262144;
constexpr size_t O_CKVP   = O_BVP + 262144;
constexpr size_t O_CKRP   = O_CKVP + 8388608;
constexpr size_t O_AKS    = O_CKRP + 1048576;
constexpr size_t O_AVS    = O_AKS + 33554432;
constexpr size_t O_BKS    = O_AVS + 33554432;
constexpr size_t O_BVS    = O_BKS + 1048576;
constexpr size_t O_CKVS   = O_BVS + 1048576;
constexpr size_t O_CKRS   = O_CKVS + 524288;
constexpr size_t O_END    = O_CKRS + 65536;
static_assert(O_END == 132186112, "output size");

constexpr size_t WS_CTL   = 0;
constexpr size_t WS_CTL_BYTES = 16384;
constexpr size_t WS_WAIN  = WS_CTL + WS_CTL_BYTES;
constexpr size_t WS_WAOUT = WS_WAIN + 2 * 8388608;
constexpr size_t WS_WBIN  = WS_WAOUT + 2 * 2097152;
constexpr size_t WS_WBOUT = WS_WBIN + 5242880;
constexpr size_t WS_WCIN  = WS_WBOUT + 2097152;
constexpr size_t WS_WCQB  = WS_WCIN + 3932160;
constexpr size_t WS_WCKVB = WS_WCQB + 1572864;
constexpr size_t WS_WCOUT = WS_WCKVB + 1048576;
constexpr size_t WS_ROPE  = WS_WCOUT + 2097152;
constexpr size_t WS_SG    = WS_ROPE + 524288;
constexpr size_t WS_X     = WS_SG + (size_t)NT * DM * 2;
constexpr size_t WS_L     = WS_X + (size_t)NT * DM * 2;
constexpr size_t WS_AQ    = WS_L;
constexpr size_t WS_AKP   = WS_AQ + (size_t)NT * DM * 2;
constexpr size_t WS_AKS   = WS_AKP + (size_t)NP * DM * 2;
constexpr size_t WS_AVTP  = WS_AKS + (size_t)32 * 576 * 1024 * 2;
constexpr size_t WS_AVTS  = WS_AVTP + (size_t)NP * DM * 2;
constexpr size_t WS_AEND  = WS_AVTS + (size_t)32 * 576 * 1024 * 2;
constexpr size_t WS_BQ    = WS_L;
constexpr size_t WS_BKP   = WS_BQ + (size_t)NT * DM * 2;
constexpr size_t WS_BKS   = WS_BKP + (size_t)NP * 256 * 2;
constexpr size_t WS_BVTP  = WS_BKS + (size_t)32 * 192 * 256 * 2;
constexpr size_t WS_BVTS  = WS_BVTP + (size_t)NP * 256 * 2;
constexpr size_t WS_BEND  = WS_BVTS + (size_t)32 * 192 * 256 * 2;
constexpr size_t WS_CZ    = WS_L;
constexpr size_t WS_CQ    = WS_L;
constexpr size_t WS_CCKVP = WS_CZ + (size_t)NT * 800 * 4;
constexpr size_t WS_CKRP  = WS_CCKVP + (size_t)NP * 256 * 2;
constexpr size_t WS_CKRS  = WS_CKRP + (size_t)NP * 32 * 2;
constexpr size_t WS_CKNS  = WS_CKRS + (size_t)32 * CKEYS * 32 * 2;
constexpr size_t WS_CVTS  = WS_CKNS + (size_t)CROUND_B * 16 * CKEYS * 64 * 2;
constexpr size_t WS_CEND  = WS_CVTS + (size_t)CROUND_B * 16 * CKEYS * 64 * 2;
constexpr size_t WS_CQA   = WS_X;
constexpr size_t WS_CCKVS = WS_CQA + (size_t)NT * 512 * 2;
static_assert(WS_CCKVS + (size_t)32 * CKEYS * 256 * 2 <= WS_L, "QA + CKVs must fit in X region");
static_assert((size_t)NT * 1536 * 2 <= (size_t)NT * 800 * 4, "Qc fits in Z region");
constexpr size_t WS_NEED  = WS_AEND > WS_CEND ? (WS_AEND > WS_BEND ? WS_AEND : WS_BEND) : (WS_CEND > WS_BEND ? WS_CEND : WS_BEND);
constexpr size_t O_SCR_KNP = O_AKS + 16777216;
constexpr size_t O_SCR_VTP = O_AVS + 16777216;

struct Params {
  const float* in[29];
  float* out;
  unsigned char* ws;
  int ph_lo, ph_hi;
};

constexpr int LDS_BYTES = 73728;
constexpr int G_STR = 144;
constexpr int G_TILE = 128 * G_STR;
constexpr int C_STR = 132;
static_assert(4 * G_TILE <= LDS_BYTES && 128 * C_STR * 4 <= LDS_BYTES, "lds");

DI void gemm_tile_to_lds(unsigned char* lds, const bf16_t* __restrict__ A, long lda, const bf16_t* __restrict__ Bt, long ldb, int K) {
  const int t = threadIdx.x, lane = t & 63, w = t >> 6, r = lane & 31, h = lane >> 5;
  const int wm = w >> 1, wn = w & 1;
  const int lrow = t >> 3, lch = t & 7;
  const bf16_t* ap = A + (long)lrow * lda + lch * 8;
  const bf16_t* bp = Bt + (long)lrow * ldb + lch * 8;
  u32x4 ra0[4], rb0[4], ra1[4], rb1[4];
  f32x16 acc00 = {}, acc01 = {}, acc10 = {}, acc11 = {};
  const int nk = K >> 6;
#define GLOAD(RA, RB, kt_) do { _Pragma("unroll") for (int i = 0; i < 4; ++i) { \
    RA[i] = *(const u32x4*)(ap + (long)(32 * i) * lda + (kt_) * 64); RB[i] = *(const u32x4*)(bp + (long)(32 * i) * ldb + (kt_) * 64); } } while (0)
#define LWRITE(RA, RB, buf_) do { _Pragma("unroll") for (int i = 0; i < 4; ++i) { \
    *(u32x4*)(lds + (buf_) * G_TILE + (lrow + 32 * i) * G_STR + lch * 16) = RA[i]; \
    *(u32x4*)(lds + 2 * G_TILE + (buf_) * G_TILE + (lrow + 32 * i) * G_STR + lch * 16) = RB[i]; } } while (0)
#define COMPUTE(buf_) do { \
    const unsigned char* ab = lds + (buf_) * G_TILE + (wm * 64 + r) * G_STR + h * 16; \
    const unsigned char* bb = lds + 2 * G_TILE + (buf_) * G_TILE + (wn * 64 + r) * G_STR + h * 16; \
    _Pragma("unroll") for (int ks = 0; ks < 4; ++ks) { \
      bf16x8 a0 = *(const bf16x8*)(ab + ks * 32); bf16x8 a1 = *(const bf16x8*)(ab + 32 * G_STR + ks * 32); \
      bf16x8 b0 = *(const bf16x8*)(bb + ks * 32); bf16x8 b1 = *(const bf16x8*)(bb + 32 * G_STR + ks * 32); \
      acc00 = MFMA(a0, b0, acc00); acc01 = MFMA(a0, b1, acc01); acc10 = MFMA(a1, b0, acc10); acc11 = MFMA(a1, b1, acc11); } } while (0)
  GLOAD(ra0, rb0, 0);
  GLOAD(ra1, rb1, 1);
  __syncthreads();
  LWRITE(ra0, rb0, 0);
  __syncthreads();
  for (int kt = 0; kt < nk; kt += 2) {
    if (kt + 2 < nk) GLOAD(ra0, rb0, kt + 2);
    COMPUTE(0);
    LWRITE(ra1, rb1, 1);
    __syncthreads();
    if (kt + 3 < nk) GLOAD(ra1, rb1, kt + 3);
    COMPUTE(1);
    if (kt + 2 < nk) LWRITE(ra0, rb0, 0);
    __syncthreads();
  }
#undef GLOAD
#undef LWRITE
#undef COMPUTE
  float* Cs = (float*)lds;
#pragma unroll
  for (int i = 0; i < 16; ++i) {
    const int rr = crow(i, h);
    Cs[(wm * 64 + rr) * C_STR + wn * 64 + r] = acc00[i];
    Cs[(wm * 64 + rr) * C_STR + wn * 64 + 32 + r] = acc01[i];
    Cs[(wm * 64 + 32 + rr) * C_STR + wn * 64 + r] = acc10[i];
    Cs[(wm * 64 + 32 + rr) * C_STR + wn * 64 + 32 + r] = acc11[i];
  }
  __syncthreads();
}

DI float row_sumsq(const float* rp, int n4) {
  float ss = 0.f;
  for (int j = 0; j < n4; ++j) { f32x4 v = *(const f32x4*)(rp + 4 * j); ss += v[0] * v[0] + v[1] * v[1] + v[2] * v[2] + v[3] * v[3]; }
  return ss;
}
DI void norm_store64(const float* rp, const float* __restrict__ g, float sc, bf16_t* dst, float fsc, float* fdst) {
#pragma unroll
  for (int j = 0; j < 8; ++j) {
    f32x4 v0 = *(const f32x4*)(rp + 8 * j), v1 = *(const f32x4*)(rp + 8 * j + 4);
    f32x4 g0 = *(const f32x4*)(g + 8 * j), g1 = *(const f32x4*)(g + 8 * j + 4);
    f32x4 x0 = v0 * g0, x1 = v1 * g1;
    u32x4 o = {pk2(x0[0] * sc, x0[1] * sc), pk2(x0[2] * sc, x0[3] * sc), pk2(x1[0] * sc, x1[1] * sc), pk2(x1[2] * sc, x1[3] * sc)};
    *(u32x4*)(dst + 8 * j) = o;
    if (fdst) { *(f32x4*)(fdst + 8 * j) = x0 * fsc; *(f32x4*)(fdst + 8 * j + 4) = x1 * fsc; }
  }
}
DI void raw_store64_f32(const float* rp, float* fdst) {
#pragma unroll
  for (int j = 0; j < 16; ++j) *(f32x4*)(fdst + 4 * j) = *(const f32x4*)(rp + 4 * j);
}
DI void silu_store64(const float* rp, bf16_t* dst) {
#pragma unroll
  for (int j = 0; j < 8; ++j) {
    f32x4 v0 = *(const f32x4*)(rp + 8 * j), v1 = *(const f32x4*)(rp + 8 * j + 4);
    u32x4 o = {pk2(silu(v0[0]), silu(v0[1])), pk2(silu(v0[2]), silu(v0[3])), pk2(silu(v1[0]), silu(v1[1])), pk2(silu(v1[2]), silu(v1[3]))};
    *(u32x4*)(dst + 8 * j) = o;
  }
}
DI void tr_store64(const float* Cs, int col, int rh, bf16_t* dst) {
#pragma unroll
  for (int g = 0; g < 8; ++g) {
    const float* p = Cs + (rh * 64 + g * 8) * C_STR + col;
    u32x4 o = {pk2(p[0], p[C_STR]), pk2(p[2 * C_STR], p[3 * C_STR]), pk2(p[4 * C_STR], p[5 * C_STR]), pk2(p[6 * C_STR], p[7 * C_STR])};
    *(u32x4*)(dst + g * 8) = o;
  }
}

struct Ctx {
  const float* const* in;
  float* out;
  unsigned char* ws;
  DI const float* xin_row(int layer, int row) const {
    if (layer == 0) return row < NP ? in[0] + (size_t)row * DM : in[1] + (size_t)(row - NP) * DM;
    return out + (size_t)row * DM;
  }
  template <class T> DI T* wsp(size_t off) const { return (T*)(ws + off); }
};

template <class Perm>
DI void wt_job(const float* __restrict__ W, int K, int N, bf16_t* __restrict__ Wt, int Np, Perm perm, long gtid, long gsz) {
  const long items = (long)Np * (K / 8);
  for (long idx = gtid; idx < items; idx += gsz) {
    const int np = (int)(idx % Np), kg = (int)(idx / Np);
    const int n = perm(np);
    u32x4 o = {0u, 0u, 0u, 0u};
    if (n >= 0) {
      const float* p = W + (size_t)(kg * 8) * N + n;
      o = (u32x4){pk2(p[0], p[(size_t)N]), pk2(p[(size_t)2 * N], p[(size_t)3 * N]), pk2(p[(size_t)4 * N], p[(size_t)5 * N]), pk2(p[(size_t)6 * N], p[(size_t)7 * N])};
    }
    *(u32x4*)(Wt + (size_t)np * K + kg * 8) = o;
  }
}
__constant__ float ROPE_INV[16] = {1.000000000e+00f, 5.623413324e-01f, 3.162277639e-01f, 1.778279394e-01f, 1.000000015e-01f, 5.623413250e-02f,
                                   3.162277490e-02f, 1.778279431e-02f, 9.999999776e-03f, 5.623413250e-03f, 3.162277630e-03f, 1.778279431e-03f,
                                   1.000000047e-03f, 5.623413017e-04f, 3.162277571e-04f, 1.778279402e-04f};
DI void phase_prep(const Ctx& c) {
  const long gtid = (long)blockIdx.x * 256 + threadIdx.x, gsz = (long)gridDim.x * 256;
  auto ident = [](int n) { return n; };
  for (int j = 0; j < 2; ++j) {
    wt_job(c.in[9] + (size_t)j * 1024 * 4096, 1024, 4096, c.wsp<bf16_t>(WS_WAIN) + (size_t)j * 4096 * 1024, 4096, ident, gtid, gsz);
    wt_job(c.in[13] + (size_t)j * 1024 * 1024, 1024, 1024, c.wsp<bf16_t>(WS_WAOUT) + (size_t)j * 1024 * 1024, 1024, ident, gtid, gsz);
  }
  wt_job(c.in[15], 1024, 2560, c.wsp<bf16_t>(WS_WBIN), 2560, ident, gtid, gsz);
  wt_job(c.in[19], 1024, 1024, c.wsp<bf16_t>(WS_WBOUT), 1024, ident, gtid, gsz);
  wt_job(c.in[21], 1024, 1824, c.wsp<bf16_t>(WS_WCIN), 1920, [](int n) { return n < 1024 ? 800 + n : (n < 1824 ? n - 1024 : -1); }, gtid, gsz);
  wt_job(c.in[23], 512, 1536, c.wsp<bf16_t>(WS_WCQB), 1536,
         [](int n) { return n < 1024 ? (n >> 6) * 96 + (n & 63) : ((n - 1024) >> 5) * 96 + 64 + ((n - 1024) & 31); }, gtid, gsz);
  wt_job(c.in[25], 256, 2048, c.wsp<bf16_t>(WS_WCKVB), 2048,
         [](int n) { return n < 1024 ? (n >> 6) * 128 + (n & 63) : ((n - 1024) >> 6) * 128 + 64 + ((n - 1024) & 63); }, gtid, gsz);
  wt_job(c.in[28], 1024, 1024, c.wsp<bf16_t>(WS_WCOUT), 1024, ident, gtid, gsz);
  float* rope = c.wsp<float>(WS_ROPE);
  for (long idx = gtid; idx < 4096 * 16; idx += gsz) {
    const int pos = (int)(idx >> 4), i = (int)(idx & 15);
    const float ang = (float)pos * ROPE_INV[i];
    const double rev = (double)ang * 0.15915494309189533577;
    const float fr = (float)(rev - floor(rev));
    rope[idx * 2] = __builtin_amdgcn_cosf(fr);
    rope[idx * 2 + 1] = __builtin_amdgcn_sinf(fr);
  }
}

DI void phase_xn(const Ctx& c, int layer, const float* __restrict__ g) {
  const int lane = threadIdx.x & 63;
  const int gw = blockIdx.x * 4 + (threadIdx.x >> 6), nw = gridDim.x * 4;
  bf16_t* xn = c.wsp<bf16_t>(WS_X);
  for (int row = gw; row < NT; row += nw) {
    const float* x = c.xin_row(layer, row);
    f32x4 v[4];
    float ss = 0.f;
#pragma unroll
    for (int i = 0; i < 2; ++i) {
      v[2 * i] = *(const f32x4*)(x + i * 512 + lane * 8);
      v[2 * i + 1] = *(const f32x4*)(x + i * 512 + lane * 8 + 4);
      ss += v[2 * i][0] * v[2 * i][0] + v[2 * i][1] * v[2 * i][1] + v[2 * i][2] * v[2 * i][2] + v[2 * i][3] * v[2 * i][3];
      ss += v[2 * i + 1][0] * v[2 * i + 1][0] + v[2 * i + 1][1] * v[2 * i + 1][1] + v[2 * i + 1][2] * v[2 * i + 1][2] + v[2 * i + 1][3] * v[2 * i + 1][3];
    }
    ss = wave_sum(ss);
    const float rinv = rsqrtf(ss * (1.f / 1024.f) + EPS);
#pragma unroll
    for (int i = 0; i < 2; ++i) {
      f32x4 g0 = *(const f32x4*)(g + i * 512 + lane * 8), g1 = *(const f32x4*)(g + i * 512 + lane * 8 + 4);
      f32x4 a = v[2 * i] * g0 * rinv, b = v[2 * i + 1] * g1 * rinv;
      u32x4 o = {pk2(a[0], a[1]), pk2(a[2], a[3]), pk2(b[0], b[1]), pk2(b[2], b[3])};
      *(u32x4*)(xn + (size_t)row * DM + i * 512 + lane * 8) = o;
    }
  }
}

DI void conv_cache(const float* __restrict__ ck, const float* __restrict__ cv, bf16_t* __restrict__ Ks, bf16_t* __restrict__ Vts,
                   float* __restrict__ ok, float* __restrict__ ov, int L, int H, int Dh) {
  const long gtid = (long)blockIdx.x * 256 + threadIdx.x, gsz = (long)gridDim.x * 256;
  const int W = H * Dh, W8 = W / 8, LT = L + 64;
  const long nk = (long)SBATCH * L * W8;
  for (long idx = gtid; idx < nk; idx += gsz) {
    const int c8 = (int)(idx % W8); const long br = idx / W8; const int row = (int)(br % L), b = (int)(br / L);
    const float* p = ck + ((size_t)b * L + row) * W + c8 * 8;
    f32x4 a = *(const f32x4*)p, d = *(const f32x4*)(p + 4);
    u32x4 o = {pk2(a[0], a[1]), pk2(a[2], a[3]), pk2(d[0], d[1]), pk2(d[2], d[3])};
    *(u32x4*)(Ks + ((size_t)b * LT + row) * W + c8 * 8) = o;
    if (row >= 64) {
      float* q = ok + ((size_t)b * L + row - 64) * W + c8 * 8;
      *(f32x4*)q = a; *(f32x4*)(q + 4) = d;
      const float* pv = cv + ((size_t)b * L + row) * W + c8 * 8;
      float* qv = ov + ((size_t)b * L + row - 64) * W + c8 * 8;
      *(f32x4*)qv = *(const f32x4*)pv; *(f32x4*)(qv + 4) = *(const f32x4*)(pv + 4);
    }
  }
  const int KG = L / 8;
  const long nv = (long)SBATCH * H * KG * Dh;
  for (long idx = gtid; idx < nv; idx += gsz) {
    const int dv = (int)(idx % Dh); long rest = idx / Dh; const int kg = (int)(rest % KG); rest /= KG; const int hh = (int)(rest % H), b = (int)(rest / H);
    const float* p = cv + ((size_t)b * L + kg * 8) * W + hh * Dh + dv;
    u32x4 o = {pk2(p[0], p[(size_t)W]), pk2(p[(size_t)2 * W], p[(size_t)3 * W]), pk2(p[(size_t)4 * W], p[(size_t)5 * W]), pk2(p[(size_t)6 * W], p[(size_t)7 * W])};
    *(u32x4*)(Vts + (((size_t)b * H + hh) * Dh + dv) * LT + kg * 8) = o;
  }
}
DI void conv_cache_c(const Ctx& c) {
  const long gtid = (long)blockIdx.x * 256 + threadIdx.x, gsz = (long)gridDim.x * 256;
  const float* ckv = c.in[6]; const float* ckr = c.in[7];
  bf16_t* CKVs = c.wsp<bf16_t>(WS_CCKVS); bf16_t* KRs = c.wsp<bf16_t>(WS_CKRS);
  const long n1 = (long)SBATCH * PAST * 32;
  for (long idx = gtid; idx < n1; idx += gsz) {
    const int c8 = (int)(idx & 31); const long br = idx >> 5; const int row = (int)(br % PAST), b = (int)(br / PAST);
    const float* p = ckv + ((size_t)b * PAST + row) * 256 + c8 * 8;
    f32x4 a = *(const f32x4*)p, d = *(const f32x4*)(p + 4);
    u32x4 o = {pk2(a[0], a[1]), pk2(a[2], a[3]), pk2(d[0], d[1]), pk2(d[2], d[3])};
    *(u32x4*)(CKVs + ((size_t)b * CKEYS + row) * 256 + c8 * 8) = o;
  }
  const long n2 = (long)SBATCH * PAST * 4;
  for (long idx = gtid; idx < n2; idx += gsz) {
    const int c8 = (int)(idx & 3); const long br = idx >> 2; const int row = (int)(br % PAST), b = (int)(br / PAST);
    const float* p = ckr + ((size_t)b * PAST + row) * 32 + c8 * 8;
    f32x4 a = *(const f32x4*)p, d = *(const f32x4*)(p + 4);
    u32x4 o = {pk2(a[0], a[1]), pk2(a[2], a[3]), pk2(d[0], d[1]), pk2(d[2], d[3])};
    *(u32x4*)(KRs + ((size_t)b * CKEYS + row) * 32 + c8 * 8) = o;
  }
}

DI void phase_gemm_a_in(const Ctx& c, unsigned char* lds, int j) {
  const bf16_t* XN = c.wsp<bf16_t>(WS_X);
  const bf16_t* Wt = c.wsp<bf16_t>(WS_WAIN) + (size_t)j * 4096 * 1024;
  const float* qg = c.in[10] + j * 128; const float* kg = c.in[11] + j * 128;
  bf16_t* Q = c.wsp<bf16_t>(WS_AQ); bf16_t* Kp = c.wsp<bf16_t>(WS_AKP); bf16_t* Ks = c.wsp<bf16_t>(WS_AKS);
  bf16_t* Vtp = c.wsp<bf16_t>(WS_AVTP); bf16_t* Vts = c.wsp<bf16_t>(WS_AVTS); bf16_t* SG = c.wsp<bf16_t>(WS_SG);
  const int t = threadIdx.x;
  const int ntiles = (NT / 128) * 32;
  for (int tile = blockIdx.x; tile < ntiles; tile += gridDim.x) {
    const int mt = tile >> 5, nt = tile & 31, m0 = mt * 128, n0 = nt * 128;
    gemm_tile_to_lds(lds, XN + (size_t)m0 * DM, DM, Wt + (size_t)n0 * DM, DM, DM);
    const float* Cs = (const float*)lds;
    const int type = nt >> 3, head = nt & 7;
    const int row = t >> 1, half = t & 1, grow = m0 + row;
    const float* rp = Cs + row * C_STR + half * 64;
    const bool prompt = m0 < NP;
    if (type == 0) {
      float ss = row_sumsq(rp, 16); ss += __shfl_xor(ss, 1);
      const float rinv = rsqrtf(ss * (1.f / 128.f) + EPS);
      norm_store64(rp, qg + half * 64, rinv * QS_A, Q + (size_t)grow * DM + head * 128 + half * 64, 0.f, nullptr);
    } else if (type == 1) {
      float ss = row_sumsq(rp, 16); ss += __shfl_xor(ss, 1);
      const float rinv = rsqrtf(ss * (1.f / 128.f) + EPS);
      bf16_t* dst; float* fdst = nullptr;
      if (prompt) {
        const int b = grow >> 12, s = grow & 4095;
        dst = Kp + (size_t)grow * DM + head * 128 + half * 64;
        if (s >= SEQ - 512) fdst = c.out + O_AKP + ((((size_t)j * PB + b) * 512 + (s - (SEQ - 512))) * 8 + head) * 128 + half * 64;
      } else {
        const int sr = grow - NP, b = sr >> 6, tt = sr & 63;
        dst = Ks + ((size_t)b * 576 + 512 + tt) * DM + head * 128 + half * 64;
        fdst = c.out + O_AKS + ((((size_t)j * SBATCH + b) * 512 + 448 + tt) * 8 + head) * 128 + half * 64;
      }
      norm_store64(rp, kg + half * 64, rinv, dst, rinv, fdst);
    } else if (type == 2) {
      float* fdst = nullptr;
      if (prompt) {
        const int b = grow >> 12, s = grow & 4095;
        if (s >= SEQ - 512) fdst = c.out + O_AVP + ((((size_t)j * PB + b) * 512 + (s - (SEQ - 512))) * 8 + head) * 128 + half * 64;
      } else {
        const int sr = grow - NP, b = sr >> 6, tt = sr & 63;
        fdst = c.out + O_AVS + ((((size_t)j * SBATCH + b) * 512 + 448 + tt) * 8 + head) * 128 + half * 64;
      }
      if (fdst) raw_store64_f32(rp, fdst);
      const int col = t & 127, rh = t >> 7;
      bf16_t* dst;
      if (prompt) { const int b = m0 >> 12, s0 = (m0 & 4095) + rh * 64; dst = Vtp + (((size_t)b * 8 + head) * 128 + col) * SEQ + s0; }
      else { const int b = ((m0 - NP) >> 6) + rh; dst = Vts + (((size_t)b * 8 + head) * 128 + col) * 576 + 512; }
      tr_store64(Cs, col, rh, dst);
    } else {
      silu_store64(rp, SG + (size_t)grow * DM + head * 128 + half * 64);
    }
  }
}

DI void phase_gemm_b_in(const Ctx& c, unsigned char* lds) {
  const bf16_t* XN = c.wsp<bf16_t>(WS_X);
  const bf16_t* Wt = c.wsp<bf16_t>(WS_WBIN);
  const float* qg = c.in[16]; const float* kg = c.in[17];
  bf16_t* Q = c.wsp<bf16_t>(WS_BQ); bf16_t* Kp = c.wsp<bf16_t>(WS_BKP); bf16_t* Ks = c.wsp<bf16_t>(WS_BKS);
  bf16_t* Vtp = c.wsp<bf16_t>(WS_BVTP); bf16_t* Vts = c.wsp<bf16_t>(WS_BVTS); bf16_t* SG = c.wsp<bf16_t>(WS_SG);
  const int t = threadIdx.x;
  const int ntiles = (NT / 128) * 20;
  for (int tile = blockIdx.x; tile < ntiles; tile += gridDim.x) {
    const int mt = tile / 20, nt = tile % 20, m0 = mt * 128, n0 = nt * 128;
    gemm_tile_to_lds(lds, XN + (size_t)m0 * DM, DM, Wt + (size_t)n0 * DM, DM, DM);
    const float* Cs = (const float*)lds;
    const int row = t >> 1, half = t & 1, grow = m0 + row;
    const float* rp = Cs + row * C_STR + half * 64;
    const bool prompt = m0 < NP;
    if (nt < 8) {
      const int head = nt * 2 + half;
      const float ss = row_sumsq(rp, 16);
      const float rinv = rsqrtf(ss * (1.f / 64.f) + EPS);
      norm_store64(rp, qg, rinv * QS_B, Q + (size_t)grow * DM + head * 64, 0.f, nullptr);
    } else if (nt < 10) {
      const int hk = (nt - 8) * 2 + half;
      const float ss = row_sumsq(rp, 16);
      const float rinv = rsqrtf(ss * (1.f / 64.f) + EPS);
      bf16_t* dst; float* fdst = nullptr;
      if (prompt) {
        const int b = grow >> 12, s = grow & 4095;
        dst = Kp + (size_t)grow * 256 + hk * 64;
        if (s >= SEQ - 128) fdst = c.out + O_BKP + (((size_t)b * 128 + (s - (SEQ - 128))) * 4 + hk) * 64;
      } else {
        const int sr = grow - NP, b = sr >> 6, tt = sr & 63;
        dst = Ks + ((size_t)b * 192 + 128 + tt) * 256 + hk * 64;
        fdst = c.out + O_BKS + (((size_t)b * 128 + 64 + tt) * 4 + hk) * 64;
      }
      norm_store64(rp, kg, rinv, dst, rinv, fdst);
    } else if (nt < 12) {
      const int hk = (nt - 10) * 2 + half;
      float* fdst = nullptr;
      if (prompt) {
        const int b = grow >> 12, s = grow & 4095;
        if (s >= SEQ - 128) fdst = c.out + O_BVP + (((size_t)b * 128 + (s - (SEQ - 128))) * 4 + hk) * 64;
      } else {
        const int sr = grow - NP, b = sr >> 6, tt = sr & 63;
        fdst = c.out + O_BVS + (((size_t)b * 128 + 64 + tt) * 4 + hk) * 64;
      }
      if (fdst) raw_store64_f32(rp, fdst);
      const int col = t & 127, rh = t >> 7, hk2 = (nt - 10) * 2 + (col >> 6), dv = col & 63;
      bf16_t* dst;
      if (prompt) { const int b = m0 >> 12, s0 = (m0 & 4095) + rh * 64; dst = Vtp + (((size_t)b * 4 + hk2) * 64 + dv) * SEQ + s0; }
      else { const int b = ((m0 - NP) >> 6) + rh; dst = Vts + (((size_t)b * 4 + hk2) * 64 + dv) * 192 + 128; }
      tr_store64(Cs, col, rh, dst);
    } else {
      silu_store64(rp, SG + (size_t)grow * DM + (nt - 12) * 128 + half * 64);
    }
  }
}

DI void phase_gemm_c_in(const Ctx& c, unsigned char* lds) {
  const bf16_t* XN = c.wsp<bf16_t>(WS_X);
  const bf16_t* Wt = c.wsp<bf16_t>(WS_WCIN);
  bf16_t* SG = c.wsp<bf16_t>(WS_SG); float* Z = c.wsp<float>(WS_CZ);
  const int t = threadIdx.x;
  const int ntiles = (NT / 128) * 15;
  for (int tile = blockIdx.x; tile < ntiles; tile += gridDim.x) {
    const int mt = tile / 15, nt = tile % 15, m0 = mt * 128, n0 = nt * 128;
    gemm_tile_to_lds(lds, XN + (size_t)m0 * DM, DM, Wt + (size_t)n0 * DM, DM, DM);
    const float* Cs = (const float*)lds;
    const int row = t >> 1, half = t & 1, grow = m0 + row;
    const float* rp = Cs + row * C_STR + half * 64;
    if (nt < 8) {
      silu_store64(rp, SG + (size_t)grow * DM + nt * 128 + half * 64);
    } else {
      const int zc0 = (nt - 8) * 128 + half * 64;
#pragma unroll
      for (int jj = 0; jj < 16; ++jj) {
        if (zc0 + 4 * jj < 800) *(f32x4*)(Z + (size_t)grow * 800 + zc0 + 4 * jj) = *(const f32x4*)(rp + 4 * jj);
      }
    }
  }
}

DI void phase_c_norm(const Ctx& c) {
  const int lane = threadIdx.x & 63;
  const int gw = blockIdx.x * 4 + (threadIdx.x >> 6), nw = gridDim.x * 4;
  const float* Z = c.wsp<float>(WS_CZ);
  bf16_t* QA = c.wsp<bf16_t>(WS_CQA);
  bf16_t* CKVp = c.wsp<bf16_t>(WS_CCKVP); bf16_t* CKVs = c.wsp<bf16_t>(WS_CCKVS);
  bf16_t* KRp = c.wsp<bf16_t>(WS_CKRP); bf16_t* KRs = c.wsp<bf16_t>(WS_CKRS);
  const float* qag = c.in[22]; const float* kvag = c.in[24]; const float* ckg = c.in[27];
  const float* rope = c.wsp<float>(WS_ROPE);
  for (int row = gw; row < NT; row += nw) {
    const float* z = Z + (size_t)row * 800;
    const bool prompt = row < NP;
    int b, s, pos;
    if (prompt) { b = row >> 12; s = row & 4095; pos = s; } else { b = (row - NP) >> 6; s = (row - NP) & 63; pos = PAST + s; }
    {
      f32x4 a = *(const f32x4*)(z + lane * 8), d = *(const f32x4*)(z + lane * 8 + 4);
      float ss = a[0] * a[0] + a[1] * a[1] + a[2] * a[2] + a[3] * a[3] + d[0] * d[0] + d[1] * d[1] + d[2] * d[2] + d[3] * d[3];
      ss = wave_sum(ss);
      const float rinv = rsqrtf(ss * (1.f / 512.f) + EPS);
      f32x4 g0 = *(const f32x4*)(qag + lane * 8), g1 = *(const f32x4*)(qag + lane * 8 + 4);
      a = a * g0 * rinv; d = d * g1 * rinv;
      u32x4 o = {pk2(a[0], a[1]), pk2(a[2], a[3]), pk2(d[0], d[1]), pk2(d[2], d[3])};
      *(u32x4*)(QA + (size_t)row * 512 + lane * 8) = o;
    }
    {
      f32x4 a = *(const f32x4*)(z + 512 + lane * 4);
      float ss = a[0] * a[0] + a[1] * a[1] + a[2] * a[2] + a[3] * a[3];
      ss = wave_sum(ss);
      const float rinv = rsqrtf(ss * (1.f / 256.f) + EPS);
      f32x4 g0 = *(const f32x4*)(kvag + lane * 4);
      a = a * g0 * rinv;
      u32x2 o = {pk2(a[0], a[1]), pk2(a[2], a[3])};
      if (prompt) {
        *(f32x4*)(c.out + O_CKVP + (size_t)row * 256 + lane * 4) = a;
        *(u32x2*)(CKVp + (size_t)row * 256 + lane * 4) = o;
      } else {
        *(f32x4*)(c.out + O_CKVS + ((size_t)b * 64 + s) * 256 + lane * 4) = a;
        *(u32x2*)(CKVs + ((size_t)b * CKEYS + PAST + s) * 256 + lane * 4) = o;
      }
    }
    {
      float v = lane < 32 ? z[768 + lane] : 0.f;
      float ss = wave_sum(v * v);
      const float rinv = rsqrtf(ss * (1.f / 32.f) + EPS);
      const float xn = v * rinv * ckg[64 + (lane & 31)];
      const float other = __shfl_xor(xn, 16);
      const int i = lane & 15;
      const float cs = rope[((size_t)pos * 16 + i) * 2], sn = rope[((size_t)pos * 16 + i) * 2 + 1];
      const float o = (lane & 16) ? (other * sn + xn * cs) : (xn * cs - other * sn);
      if (lane < 32) {
        const unsigned ob = pk2(o, 0.f) & 0xffffu;
        if (prompt) {
          c.out[O_CKRP + (size_t)row * 32 + lane] = o;
          KRp[(size_t)row * 32 + lane] = (bf16_t)ob;
        } else {
          c.out[O_CKRS + ((size_t)b * 64 + s) * 32 + lane] = o;
          KRs[((size_t)b * CKEYS + PAST + s) * 32 + lane] = (bf16_t)ob;
        }
      }
    }
  }
}

DI void c_q_tile(const Ctx& c, unsigned char* lds, int mt, int nt) {
  const bf16_t* QA = c.wsp<bf16_t>(WS_CQA);
  const bf16_t* Wt = c.wsp<bf16_t>(WS_WCQB);
  bf16_t* Qc = c.wsp<bf16_t>(WS_CQ);
  const float* cqg = c.in[26];
  const float* rope = c.wsp<float>(WS_ROPE);
  const int t = threadIdx.x;
  const int m0 = mt * 128, n0 = nt * 128;
  gemm_tile_to_lds(lds, QA + (size_t)m0 * 512, 512, Wt + (size_t)n0 * 512, 512, 512);
  const float* Cs = (const float*)lds;
  const int row = t >> 1, half = t & 1, grow = m0 + row;
  const float* rp = Cs + row * C_STR + half * 64;
  if (nt < 8) {
    const int head = nt * 2 + half;
    const float ss = row_sumsq(rp, 16);
    const float rinv = rsqrtf(ss * (1.f / 64.f) + EPS);
    norm_store64(rp, cqg, rinv * QS_C, Qc + (size_t)grow * 1536 + head * 96, 0.f, nullptr);
  } else {
    const int pos = grow < NP ? (grow & 4095) : PAST + ((grow - NP) & 63);
    const float* rt = rope + (size_t)pos * 32;
#pragma unroll
    for (int sub = 0; sub < 2; ++sub) {
      const int head = (nt - 8) * 4 + half * 2 + sub;
      const float* xp = rp + sub * 32;
      const float ss = row_sumsq(xp, 8);
      const float sc = rsqrtf(ss * (1.f / 32.f) + EPS);
      bf16_t* dst = Qc + (size_t)grow * 1536 + head * 96 + 64;
#pragma unroll
      for (int q4 = 0; q4 < 4; ++q4) {
        f32x4 x1 = *(const f32x4*)(xp + 4 * q4), x2 = *(const f32x4*)(xp + 16 + 4 * q4);
        f32x4 g1 = *(const f32x4*)(cqg + 64 + 4 * q4), g2 = *(const f32x4*)(cqg + 80 + 4 * q4);
        x1 = x1 * g1 * sc; x2 = x2 * g2 * sc;
        f32x4 cs01 = *(const f32x4*)(rt + 8 * q4), cs23 = *(const f32x4*)(rt + 8 * q4 + 4);
        float o1[4], o2[4];
        o1[0] = x1[0] * cs01[0] - x2[0] * cs01[1]; o2[0] = x1[0] * cs01[1] + x2[0] * cs01[0];
        o1[1] = x1[1] * cs01[2] - x2[1] * cs01[3]; o2[1] = x1[1] * cs01[3] + x2[1] * cs01[2];
        o1[2] = x1[2] * cs23[0] - x2[2] * cs23[1]; o2[2] = x1[2] * cs23[1] + x2[2] * cs23[0];
        o1[3] = x1[3] * cs23[2] - x2[3] * cs23[3]; o2[3] = x1[3] * cs23[3] + x2[3] * cs23[2];
        u32x2 a = {pk2(o1[0] * QS_C, o1[1] * QS_C), pk2(o1[2] * QS_C, o1[3] * QS_C)};
        u32x2 d = {pk2(o2[0] * QS_C, o2[1] * QS_C), pk2(o2[2] * QS_C, o2[3] * QS_C)};
        *(u32x2*)(dst + 4 * q4) = a;
        *(u32x2*)(dst + 16 + 4 * q4) = d;
      }
    }
  }
}
DI void c_kv_tile(const Ctx& c, unsigned char* lds, const bf16_t* A, bf16_t* Kn, bf16_t* Vt, int rows_per_b, int mt, int nt) {
  const bf16_t* Wt = c.wsp<bf16_t>(WS_WCKVB);
  const float* ckg = c.in[27];
  const int t = threadIdx.x;
  const int m0 = mt * 128, n0 = nt * 128;
  gemm_tile_to_lds(lds, A + (size_t)m0 * 256, 256, Wt + (size_t)n0 * 256, 256, 256);
  const float* Cs = (const float*)lds;
  if (nt < 8) {
    const int row = t >> 1, half = t & 1, grow = m0 + row;
    const float* rp = Cs + row * C_STR + half * 64;
    const int head = nt * 2 + half;
    const int b = grow / rows_per_b, s = grow - b * rows_per_b;
    const float ss = row_sumsq(rp, 16);
    const float rinv = rsqrtf(ss * (1.f / 64.f) + EPS);
    norm_store64(rp, ckg, rinv, Kn + (((size_t)b * 16 + head) * rows_per_b + s) * 64, 0.f, nullptr);
  } else {
    const int col = t & 127, rh = t >> 7, head = (nt - 8) * 2 + (col >> 6), dv = col & 63;
    const int rr = m0 + rh * 64, b = rr / rows_per_b, s0 = rr - b * rows_per_b;
    tr_store64(Cs, col, rh, Vt + (((size_t)b * 16 + head) * 64 + dv) * rows_per_b + s0);
  }
}
DI void phase_c_proj(const Ctx& c, unsigned char* lds, int round) {
  const int nq = round == 0 ? (NT / 128) * 12 : 0;
  const int nkp = round == 0 ? (NP / 128) * 16 : 0;
  const int nks = (CROUND_B * CKEYS / 128) * 16;
  bf16_t* Knp = (bf16_t*)(c.out + O_SCR_KNP); bf16_t* Vtp = (bf16_t*)(c.out + O_SCR_VTP);
  const int total = nq + nkp + nks;
  for (int tile = blockIdx.x; tile < total; tile += gridDim.x) {
    if (tile < nq) c_q_tile(c, lds, tile / 12, tile % 12);
    else if (tile < nq + nkp) { const int u = tile - nq; c_kv_tile(c, lds, c.wsp<bf16_t>(WS_CCKVP), Knp, Vtp, SEQ, u >> 4, u & 15); }
    else { const int u = tile - nq - nkp;
      c_kv_tile(c, lds, c.wsp<bf16_t>(WS_CCKVS) + (size_t)round * CROUND_B * CKEYS * 256, c.wsp<bf16_t>(WS_CKNS), c.wsp<bf16_t>(WS_CVTS), CKEYS, u >> 4, u & 15); }
  }
}

DI void phase_gemm_out(const Ctx& c, unsigned char* lds, int layer, const bf16_t* Wt, bool dry) {
  const bf16_t* OG = c.wsp<bf16_t>(WS_SG);
  const int t = threadIdx.x;
  const int ntiles = (NT / 128) * 8;
  for (int tile = blockIdx.x; tile < ntiles; tile += gridDim.x) {
    const int mt = tile >> 3, nt = tile & 7, m0 = mt * 128, n0 = nt * 128;
    gemm_tile_to_lds(lds, OG + (size_t)m0 * DM, DM, Wt + (size_t)n0 * DM, DM, DM);
    const float* Cs = (const float*)lds;
    const int row = t >> 1, half = t & 1, grow = m0 + row;
    const float* rp = Cs + row * C_STR + half * 64;
    const float* xo = c.xin_row(layer, grow) + n0 + half * 64;
    float* xn = c.out + (size_t)grow * DM + n0 + half * 64;
#pragma unroll
    for (int jj = 0; jj < 16; ++jj) {
      f32x4 a = *(const f32x4*)(xo + 4 * jj);
      if (!dry) *(f32x4*)(xn + 4 * jj) = a + *(const f32x4*)(rp + 4 * jj);
    }
  }
}

struct AttnItem {
  const bf16_t* k1; long ks1;
  const bf16_t* k2; long ks2;
  const bf16_t* vt; long vts;
  int t0, t1;
  const bf16_t* qrow;
  long qs;
  bf16_t* og;
  int cw;
  int qi0;
  float bslope;
  float m0, l0;
  bool dry;
};

template <int DQK, int DV, int BIAS, int BAND, int KCH1>
DI void attn_item(unsigned char* lds, const AttnItem& it) {
  constexpr int KSTR = DQK * 2 + 16, VSTR = 136;
  constexpr int KBYTES = 64 * KSTR, VBYTES = DV * VSTR;
  constexpr int KCH = DQK / 8, NKL = 64 * KCH / 256, NVL = DV * 8 / 256;
  constexpr int NKS = DQK / 16, NDB = DV / 32;
  static_assert(2 * KBYTES + 2 * VBYTES + 1040 <= LDS_BYTES, "attn lds");
  const int t = threadIdx.x, lane = t & 63, r = lane & 31, h = lane >> 5;
  unsigned char* Kl = lds; unsigned char* Vl = lds + 2 * KBYTES;
  const float* tab = (const float*)(lds + 2 * KBYTES + 2 * VBYTES);
  bf16x8 qf[NKS];
  {
    const bf16_t* qp = it.qrow + (long)r * it.qs + h * 8;
#pragma unroll
    for (int ks = 0; ks < NKS; ++ks) qf[ks] = *(const bf16x8*)(qp + ks * 16);
  }
  f32x16 o[NDB];
#pragma unroll
  for (int d = 0; d < NDB; ++d) o[d] = f32x16{};
  float m = it.m0, l = it.l0;
  u32x4 kr[NKL]; u32x4 vr[NVL];
  auto gload = [&](int tile) {
#pragma unroll
    for (int i = 0; i < NKL; ++i) {
      const int e = t + 256 * i, row = e / KCH, ch = e - row * KCH;
      const long key = (long)tile * 64 + row;
      const bf16_t* src = (ch < KCH1) ? it.k1 + key * it.ks1 + ch * 8 : it.k2 + key * it.ks2 + (ch - KCH1) * 8;
      kr[i] = *(const u32x4*)src;
    }
#pragma unroll
    for (int i = 0; i < NVL; ++i) {
      const int e = t + 256 * i, dv = e >> 3, ch = e & 7;
      vr[i] = *(const u32x4*)(it.vt + (long)dv * it.vts + (long)tile * 64 + ch * 8);
    }
  };
  auto lwrite = [&](int buf) {
#pragma unroll
    for (int i = 0; i < NKL; ++i) {
      const int e = t + 256 * i, row = e / KCH, ch = e - row * KCH;
      *(u32x4*)(Kl + buf * KBYTES + row * KSTR + ch * 16) = kr[i];
    }
#pragma unroll
    for (int i = 0; i < NVL; ++i) {
      const int e = t + 256 * i, dv = e >> 3, ch = e & 7;
      unsigned char* d = Vl + buf * VBYTES + dv * VSTR + ch * 16;
      *(u32x2*)d = (u32x2){vr[i][0], vr[i][1]};
      *(u32x2*)(d + 8) = (u32x2){vr[i][2], vr[i][3]};
    }
  };
  gload(it.t0);
  __syncthreads();
  lwrite(0);
  __syncthreads();
  const int ntile = it.t1 - it.t0 + 1;
  for (int jt = 0; jt < ntile; ++jt) {
    const int buf = jt & 1, tile = it.t0 + jt;
    if (jt + 1 < ntile) gload(tile + 1);
    const bool active = (tile <= it.cw) && (tile >= it.cw - (BAND - 1));
    if (active) {
      f32x16 s0, s1;
      const int dt = it.cw - tile;
      const int dbase = dt * 64 + it.qi0 + r - 4 * h;
      if (BIAS == 1) {
        if (dt >= 3) { const float cb = tab[256];
#pragma unroll
          for (int i = 0; i < 16; ++i) { s0[i] = cb; s1[i] = cb; }
        } else {
#pragma unroll
          for (int i = 0; i < 16; ++i) {
            const int d0 = dbase - ((i & 3) + 8 * (i >> 2));
            s0[i] = tab[min(max(d0, -128), 128) + 128];
            s1[i] = tab[min(max(d0 - 32, -128), 128) + 128];
          }
        }
      } else if (BIAS == 2) {
#pragma unroll
        for (int i = 0; i < 16; ++i) {
          const int d0 = dbase - ((i & 3) + 8 * (i >> 2));
          s0[i] = -it.bslope * fabsf((float)d0);
          s1[i] = -it.bslope * fabsf((float)(d0 - 32));
        }
      } else {
#pragma unroll
        for (int i = 0; i < 16; ++i) { s0[i] = 0.f; s1[i] = 0.f; }
      }
      const unsigned char* kb = Kl + buf * KBYTES + r * KSTR + h * 16;
#pragma unroll
      for (int ks = 0; ks < NKS; ++ks) {
        bf16x8 k0 = *(const bf16x8*)(kb + ks * 32);
        bf16x8 k1 = *(const bf16x8*)(kb + 32 * KSTR + ks * 32);
        s0 = MFMA(k0, qf[ks], s0);
        s1 = MFMA(k1, qf[ks], s1);
      }
      float mx = s0[0];
#pragma unroll
      for (int i = 1; i < 16; ++i) mx = fmaxf(mx, s0[i]);
#pragma unroll
      for (int i = 0; i < 16; ++i) mx = fmaxf(mx, s1[i]);
      mx = fmaxf(mx, __shfl_xor(mx, 32));
      const float mn = fmaxf(m, mx);
      const float alpha = fast_exp2(m - mn);
      m = mn;
      float rs = 0.f;
#pragma unroll
      for (int i = 0; i < 16; ++i) { s0[i] = fast_exp2(s0[i] - mn); s1[i] = fast_exp2(s1[i] - mn); rs += s0[i] + s1[i]; }
      rs += __shfl_xor(rs, 32);
      l = l * alpha + rs;
#pragma unroll
      for (int d = 0; d < NDB; ++d)
#pragma unroll
        for (int i = 0; i < 16; ++i) o[d][i] *= alpha;
      bf16x8 pf[4];
      {
        u32x4 a = {pk2(s0[0], s0[1]), pk2(s0[2], s0[3]), pk2(s0[4], s0[5]), pk2(s0[6], s0[7])};
        u32x4 b = {pk2(s0[8], s0[9]), pk2(s0[10], s0[11]), pk2(s0[12], s0[13]), pk2(s0[14], s0[15])};
        u32x4 cc = {pk2(s1[0], s1[1]), pk2(s1[2], s1[3]), pk2(s1[4], s1[5]), pk2(s1[6], s1[7])};
        u32x4 dd = {pk2(s1[8], s1[9]), pk2(s1[10], s1[11]), pk2(s1[12], s1[13]), pk2(s1[14], s1[15])};
        pf[0] = __builtin_bit_cast(bf16x8, a); pf[1] = __builtin_bit_cast(bf16x8, b);
        pf[2] = __builtin_bit_cast(bf16x8, cc); pf[3] = __builtin_bit_cast(bf16x8, dd);
      }
      const unsigned char* vb = Vl + buf * VBYTES + r * VSTR + h * 8;
#pragma unroll
      for (int d = 0; d < NDB; ++d) {
#pragma unroll
        for (int kk = 0; kk < 4; ++kk) {
          const unsigned char* p = vb + d * 32 * VSTR + kk * 32;
          s16x4 lo = *(const s16x4*)p, hi = *(const s16x4*)(p + 16);
          bf16x8 vf = {lo[0], lo[1], lo[2], lo[3], hi[0], hi[1], hi[2], hi[3]};
          o[d] = MFMA(vf, pf[kk], o[d]);
        }
      }
    }
    if (jt + 1 < ntile) lwrite(buf ^ 1);
    __syncthreads();
  }
  if (it.cw >= 0 && !it.dry) {
    const float linv = 1.f / l;
    bf16_t* op = it.og + (long)r * DM + 4 * h;
#pragma unroll
    for (int d = 0; d < NDB; ++d) {
#pragma unroll
      for (int g = 0; g < 4; ++g) {
        bf16_t* p = op + d * 32 + 8 * g;
        const u32x2 sg = *(const u32x2*)p;
        u32x2 ov = {pk2(o[d][4 * g] * linv * bf_lo(sg[0]), o[d][4 * g + 1] * linv * bf_hi(sg[0])),
                    pk2(o[d][4 * g + 2] * linv * bf_lo(sg[1]), o[d][4 * g + 3] * linv * bf_hi(sg[1]))};
        *(u32x2*)p = ov;
      }
    }
  }
}

DI void phase_attn_a(const Ctx& c, unsigned char* lds, int j, bool dry) {
  const int w = __builtin_amdgcn_readfirstlane(threadIdx.x >> 6);
  const bf16_t* Q = c.wsp<bf16_t>(WS_AQ); const bf16_t* Kp = c.wsp<bf16_t>(WS_AKP); const bf16_t* Ks = c.wsp<bf16_t>(WS_AKS);
  const bf16_t* Vtp = c.wsp<bf16_t>(WS_AVTP); const bf16_t* Vts = c.wsp<bf16_t>(WS_AVTS); bf16_t* SG = c.wsp<bf16_t>(WS_SG);
  const float* rel = c.in[12] + (size_t)j * 8 * 257;
  float* tab = (float*)(lds + 2 * 64 * (128 * 2 + 16) + 2 * 128 * 136);
  const int nitems = 2048 + 256;
  for (int item = blockIdx.x; item < nitems; item += gridDim.x) {
    AttnItem it;
    int hh;
    if (item < 2048) {
      const int p = item >> 6, bh = item & 63, b = bh >> 3; hh = bh & 7;
      const int c0 = 2 * p;
      it.k1 = Kp + (size_t)b * SEQ * DM + hh * 128; it.ks1 = DM;
      it.vt = Vtp + ((size_t)b * 8 + hh) * 128 * SEQ; it.vts = SEQ;
      it.t0 = c0 - 8 > 0 ? c0 - 8 : 0; it.t1 = c0 + 1;
      it.cw = c0 + (w >> 1); it.qi0 = (w & 1) * 32;
      const size_t tok = (size_t)b * SEQ + it.cw * 64 + it.qi0;
      it.qrow = Q + tok * DM + hh * 128; it.og = SG + tok * DM + hh * 128;
    } else {
      const int u = item - 2048, b = u >> 3; hh = u & 7;
      it.k1 = Ks + (size_t)b * 576 * DM + hh * 128; it.ks1 = DM;
      it.vt = Vts + ((size_t)b * 8 + hh) * 128 * 576; it.vts = 576;
      it.t0 = 0; it.t1 = 8;
      it.cw = w < 2 ? 8 : -1000; it.qi0 = (w & 1) * 32;
      const size_t tok = (size_t)NP + b * 64 + it.qi0;
      it.qrow = Q + tok * DM + hh * 128; it.og = SG + tok * DM + hh * 128;
    }
    it.k2 = it.k1; it.ks2 = 0; it.qs = DM; it.bslope = 0.f; it.m0 = -1e30f; it.l0 = 0.f; it.dry = dry;
    __syncthreads();
    for (int i = threadIdx.x; i < 257; i += 256) tab[i] = rel[hh * 257 + i] * LOG2E;
    attn_item<128, 128, 1, 9, 16>(lds, it);
  }
}
DI void phase_attn_b(const Ctx& c, unsigned char* lds, bool dry) {
  const int w = __builtin_amdgcn_readfirstlane(threadIdx.x >> 6);
  const bf16_t* Q = c.wsp<bf16_t>(WS_BQ); const bf16_t* Kp = c.wsp<bf16_t>(WS_BKP); const bf16_t* Ks = c.wsp<bf16_t>(WS_BKS);
  const bf16_t* Vtp = c.wsp<bf16_t>(WS_BVTP); const bf16_t* Vts = c.wsp<bf16_t>(WS_BVTS); bf16_t* SG = c.wsp<bf16_t>(WS_SG);
  const float* sinks = c.in[18];
  const int nitems = 4096 + 256;
  for (int item = blockIdx.x; item < nitems; item += gridDim.x) {
    AttnItem it;
    int head;
    if (item < 4096) {
      const int gp = item & 1, hk = (item >> 1) & 3, cc = (item >> 3) & 63, b = item >> 9;
      head = hk * 4 + gp * 2 + (w >> 1);
      it.k1 = Kp + (size_t)b * SEQ * 256 + hk * 64; it.ks1 = 256;
      it.vt = Vtp + ((size_t)b * 4 + hk) * 64 * SEQ; it.vts = SEQ;
      it.t0 = cc - 2 > 0 ? cc - 2 : 0; it.t1 = cc;
      it.cw = cc; it.qi0 = (w & 1) * 32;
      const size_t tok = (size_t)b * SEQ + cc * 64 + it.qi0;
      it.qrow = Q + tok * DM + head * 64; it.og = SG + tok * DM + head * 64;
    } else {
      const int u = item - 4096, gp = u & 1, hk = (u >> 1) & 3, b = u >> 3;
      head = hk * 4 + gp * 2 + (w >> 1);
      it.k1 = Ks + (size_t)b * 192 * 256 + hk * 64; it.ks1 = 256;
      it.vt = Vts + ((size_t)b * 4 + hk) * 64 * 192; it.vts = 192;
      it.t0 = 0; it.t1 = 2;
      it.cw = 2; it.qi0 = (w & 1) * 32;
      const size_t tok = (size_t)NP + b * 64 + it.qi0;
      it.qrow = Q + tok * DM + head * 64; it.og = SG + tok * DM + head * 64;
    }
    it.k2 = it.k1; it.ks2 = 0; it.qs = DM;
    it.bslope = exp2f(-0.5f * (float)(head + 1)) * LOG2E;
    it.m0 = sinks[head] * LOG2E; it.l0 = 1.f; it.dry = dry;
    attn_item<64, 64, 2, 3, 8>(lds, it);
  }
}
DI void phase_attn_c(const Ctx& c, unsigned char* lds, int round, bool dry) {
  const int w = __builtin_amdgcn_readfirstlane(threadIdx.x >> 6);
  const bf16_t* Qc = c.wsp<bf16_t>(WS_CQ); bf16_t* SG = c.wsp<bf16_t>(WS_SG);
  const bf16_t* Knp = (const bf16_t*)(c.out + O_SCR_KNP); const bf16_t* Vtp = (const bf16_t*)(c.out + O_SCR_VTP);
  const bf16_t* KRp = c.wsp<bf16_t>(WS_CKRP); const bf16_t* KRs = c.wsp<bf16_t>(WS_CKRS);
  const bf16_t* Kns = c.wsp<bf16_t>(WS_CKNS); const bf16_t* Vts = c.wsp<bf16_t>(WS_CVTS);
  const int npr = round == 0 ? 4096 : 0;
  const int nitems = npr + CROUND_B * 16;
  for (int item = blockIdx.x; item < nitems; item += gridDim.x) {
    AttnItem it;
    if (item < npr) {
      const int p = 31 - (item >> 7), bh = item & 127, b = bh >> 4, hh = bh & 15;
      it.k1 = Knp + ((size_t)b * 16 + hh) * SEQ * 64; it.ks1 = 64;
      it.k2 = KRp + (size_t)b * SEQ * 32; it.ks2 = 32;
      it.vt = Vtp + ((size_t)b * 16 + hh) * 64 * SEQ; it.vts = SEQ;
      it.t0 = 0; it.t1 = 2 * p + 1;
      it.cw = 2 * p + (w >> 1); it.qi0 = (w & 1) * 32;
      const size_t tok = (size_t)b * SEQ + it.cw * 64 + it.qi0;
      it.qrow = Qc + tok * 1536 + hh * 96; it.og = SG + tok * DM + hh * 64;
    } else {
      const int u = item - npr, bl = u >> 4, hh = u & 15, b = round * CROUND_B + bl;
      it.k1 = Kns + ((size_t)bl * 16 + hh) * CKEYS * 64; it.ks1 = 64;
      it.k2 = KRs + (size_t)b * CKEYS * 32; it.ks2 = 32;
      it.vt = Vts + ((size_t)bl * 16 + hh) * 64 * CKEYS; it.vts = CKEYS;
      it.t0 = 0; it.t1 = 32;
      it.cw = w < 2 ? 32 : -1000; it.qi0 = (w & 1) * 32;
      const size_t tok = (size_t)NP + b * 64 + it.qi0;
      it.qrow = Qc + tok * 1536 + hh * 96; it.og = SG + tok * DM + hh * 64;
    }
    it.qs = 1536; it.bslope = 0.f; it.m0 = -1e30f; it.l0 = 0.f; it.dry = dry;
    attn_item<96, 64, 0, 100000, 8>(lds, it);
  }
}

constexpr int N_PHASES = 20;
__global__ void __launch_bounds__(256, 2) mega(Params P) {
  __shared__ __attribute__((aligned(16))) unsigned char lds[LDS_BYTES + 16];
  Ctx c{P.in, P.out, P.ws};
  const int lo = P.ph_lo, hi = P.ph_hi;
#if MODE_COOP
  if (threadIdx.x < 4) ((volatile LAS unsigned*)(lds + LDS_BYTES))[threadIdx.x] = 0u;
  __syncthreads();
  XcdBarrier xbar = xcd_barrier_post((unsigned*)(P.ws + WS_CTL), (volatile LAS unsigned*)(lds + LDS_BYTES));
  if (P.ph_lo < 0) cg::this_grid().sync();
#endif
#define IN(k) (lo <= (k) && (k) < hi)
#if MODE_COOP
#define SEAM(k) do { if (IN(k) && IN((k) + 1)) xcd_barrier(xbar); } while (0)
#else
#define SEAM(k) do { } while (0)
#endif
  const bool dryf = P.ph_lo >= 0;
#define RUN(k, ...) do { if (IN(k)) { if ((PROBE_DUP >> (k)) & 1u) { const bool dry = dryf; __VA_ARGS__; } { const bool dry = false; __VA_ARGS__; } } SEAM(k); } while (0)
  RUN(0, (void)dry; phase_prep(c); phase_xn(c, 0, c.in[8]);
         conv_cache(c.in[2], c.in[3], c.wsp<bf16_t>(WS_AKS), c.wsp<bf16_t>(WS_AVTS), c.out + O_AKS, c.out + O_AVS, 512, 8, 128));
  RUN(1, (void)dry; phase_gemm_a_in(c, lds, 0));
  RUN(2, phase_attn_a(c, lds, 0, dry));
  RUN(3, phase_gemm_out(c, lds, 0, c.wsp<bf16_t>(WS_WAOUT), dry));
  RUN(4, (void)dry; phase_xn(c, 1, c.in[14]);
         conv_cache(c.in[4], c.in[5], c.wsp<bf16_t>(WS_BKS), c.wsp<bf16_t>(WS_BVTS), c.out + O_BKS, c.out + O_BVS, 128, 4, 64));
  RUN(5, (void)dry; phase_gemm_b_in(c, lds));
  RUN(6, phase_attn_b(c, lds, dry));
  RUN(7, phase_gemm_out(c, lds, 1, c.wsp<bf16_t>(WS_WBOUT), dry));
  RUN(8, (void)dry; phase_xn(c, 2, c.in[20]));
  RUN(9, (void)dry; phase_gemm_c_in(c, lds));
  RUN(10, (void)dry; phase_c_norm(c); conv_cache_c(c));
  RUN(11, (void)dry; phase_c_proj(c, lds, 0));
  RUN(12, phase_attn_c(c, lds, 0, dry));
  RUN(13, (void)dry; phase_c_proj(c, lds, 1));
  RUN(14, phase_attn_c(c, lds, 1, dry));
  RUN(15, phase_gemm_out(c, lds, 2, c.wsp<bf16_t>(WS_WCOUT), dry));
  RUN(16, (void)dry; phase_xn(c, 3, c.in[8] + 1024);
          conv_cache(c.in[2] + (size_t)SBATCH * 512 * 1024, c.in[3] + (size_t)SBATCH * 512 * 1024, c.wsp<bf16_t>(WS_AKS), c.wsp<bf16_t>(WS_AVTS),
                     c.out + O_AKS + 16777216, c.out + O_AVS + 16777216, 512, 8, 128));
  RUN(17, (void)dry; phase_gemm_a_in(c, lds, 1));
  RUN(18, phase_attn_a(c, lds, 1, dry));
  RUN(19, phase_gemm_out(c, lds, 3, c.wsp<bf16_t>(WS_WAOUT) + (size_t)1024 * 1024, dry));
#undef RUN
#undef IN
#undef SEAM
}

extern "C" void kernel_launch(void* const* d_in, const int* in_sizes, int n_in, void* d_out, int out_size, void* d_ws, size_t ws_size, hipStream_t stream) {
  static int grid = 0;
  if (grid == 0) {
    if (n_in != 29 || (size_t)out_size != O_END || ws_size < WS_NEED) {
      fprintf(stderr, "kernel_launch: unexpected shapes: n_in %d out %d ws %zu (need %zu)\n", n_in, out_size, ws_size, (size_t)WS_NEED);
      grid = -1; return;
    }
    int dev = 0, cus = 0, per_cu = 0;
    hipGetDevice(&dev);
    hipDeviceGetAttribute(&cus, hipDeviceAttributeMultiprocessorCount, dev);
    hipOccupancyMaxActiveBlocksPerMultiprocessor(&per_cu, (const void*)mega, 256, 0);
    if (per_cu < 1) { fprintf(stderr, "kernel_launch: occupancy query returned %d\n", per_cu); grid = -1; return; }
    if (per_cu > 2) per_cu = 2;
    grid = cus * per_cu;
    fprintf(stderr, "kernel_launch: grid %d (%d CUs x %d)\n", grid, cus, per_cu);
  }
  if (grid < 0) return;
  Params p{};
  for (int i = 0; i < 29; ++i) p.in[i] = (const float*)d_in[i];
  p.out = (float*)d_out; p.ws = (unsigned char*)d_ws;
#if MODE_COOP
  if (hipMemsetAsync((char*)d_ws + WS_CTL, 0, WS_CTL_BYTES, stream) != hipSuccess) { fprintf(stderr, "kernel_launch: memset failed\n"); return; }
  p.ph_lo = 0; p.ph_hi = N_PHASES;
  void* args[] = {&p};
  hipError_t e = hipLaunchCooperativeKernel((const void*)mega, dim3(grid), dim3(256), args, 0, stream);
  if (e != hipSuccess) fprintf(stderr, "cooperative launch failed: %s (grid %d)\n", hipGetErrorString(e), grid);
#else
  for (int ph = 0; ph < 20; ++ph) {
    p.ph_lo = ph; p.ph_hi = ph + 1;
    hipLaunchKernelGGL(mega, dim3(grid), dim3(256), 0, stream, p);
  }
#endif
}
```

```cpp
#include <hip/hip_runtime.h>
#include <hip/hip_cooperative_groups.h>
#include <cstdio>
#include <cstdint>
namespace cg = cooperative_groups;

#ifndef MODE_COOP
#define MODE_COOP 1
#endif
#ifndef PROBE_MODE
#define PROBE_MODE 0
#endif
#ifndef PROBE_DUP
#define PROBE_DUP 0u
#endif

#define DI __device__ __forceinline__
typedef unsigned short bf16_t;
using bf16x8 = __attribute__((ext_vector_type(8))) short;
using s16x4  = __attribute__((ext_vector_type(4))) short;
using f32x16 = __attribute__((ext_vector_type(16))) float;
using f32x4  = __attribute__((ext_vector_type(4))) float;
using u32x4  = __attribute__((ext_vector_type(4))) unsigned;
using u32x2  = __attribute__((ext_vector_type(2))) unsigned;
typedef __bf16 bf2_t __attribute__((ext_vector_type(2)));
typedef float f2_t __attribute__((ext_vector_type(2)));
#define MFMA(a, b, c) __builtin_amdgcn_mfma_f32_32x32x16_bf16((a), (b), (c), 0, 0, 0)

DI unsigned pk2(float lo, float hi) { f2_t v = {lo, hi}; return __builtin_bit_cast(unsigned, __builtin_convertvector(v, bf2_t)); }
DI float bf_lo(unsigned u) { return __uint_as_float(u << 16); }
DI float bf_hi(unsigned u) { return __uint_as_float(u & 0xffff0000u); }
DI int crow(int i, int h) { return (i & 3) + 8 * (i >> 2) + 4 * h; }
DI float wave_sum(float v) {
#pragma unroll
  for (int o = 32; o >= 1; o >>= 1) v += __shfl_xor(v, o);
  return v;
}
DI float fast_exp2(float x) { return __builtin_amdgcn_exp2f(x); }
DI float silu(float g) { return g / (1.f + __expf(-g)); }

#define XB_TMO      128
#define XB_XCNT(j)  (256  + 64 * (j))
#define XB_XSUB(j)  (1280 + 64 * (j))
#define XB_XGEN(j)  (2304 + 64 * (j))
#define XB_TOP      3328
#define XB_TOPGEN   3392
#define XCD_BAR_WORDS 3456
#define XB_SPIN_CAP (1u << 22)
#define LAS __attribute__((address_space(3)))
DI unsigned xb_ld(unsigned* p)              { return __hip_atomic_load(p, __ATOMIC_RELAXED, __HIP_MEMORY_SCOPE_AGENT); }
DI unsigned xb_add(unsigned* p, unsigned v) { return __hip_atomic_fetch_add(p, v, __ATOMIC_RELAXED, __HIP_MEMORY_SCOPE_AGENT); }
DI unsigned xb_xcc_id() { return (unsigned)__builtin_amdgcn_s_getreg((3 << 11) | 20) & 0xFu; }
#define XB_SPIN(cond, bar) do { unsigned _sp = 0; while (cond) { __builtin_amdgcn_s_sleep(1); \
    if ((++_sp & 255u) == 0u) { if (xb_ld(&(bar)[XB_TMO])) break; if (_sp > XB_SPIN_CAP) { atomicAdd(&(bar)[XB_TMO], 1u); break; } } } } while (0)
struct XcdBarrier { unsigned* bar; unsigned x; volatile LAS unsigned* st; };
DI XcdBarrier xcd_barrier_post(unsigned* bar, volatile LAS unsigned* st) {
  XcdBarrier b; b.bar = bar; b.x = xb_xcc_id(); b.st = st;
  if (threadIdx.x == 0) (void)xb_add(&bar[XB_XCNT(b.x)], 1u);
  return b;
}
DI void xcd_barrier_complete(unsigned* bar, unsigned x, unsigned& nloc, unsigned& nx) {
  const unsigned G = gridDim.x * gridDim.y * gridDim.z;
  unsigned sum, cnt, mine, sp = 0u;
  for (;;) {
    sum = 0u; cnt = 0u; mine = 0u;
#pragma unroll
    for (unsigned j = 0; j < 16; ++j) { const unsigned c = xb_ld(&bar[XB_XCNT(j)]); sum += c; cnt += (c > 0u) ? 1u : 0u; mine = (j == x) ? c : mine; }
    if (sum == G) break;
    __builtin_amdgcn_s_sleep(1);
    if ((++sp & 255u) == 0u) { if (xb_ld(&bar[XB_TMO])) break; if (sp > XB_SPIN_CAP) { atomicAdd(&bar[XB_TMO], 1u); break; } }
  }
  nloc = mine > 0u ? mine : 1u; nx = cnt > 0u ? cnt : 1u;
}
DI void xcd_barrier(const XcdBarrier& b) {
  asm volatile("s_waitcnt vmcnt(0)" ::: "memory");
  __syncthreads();
  if (threadIdx.x == 0) {
    unsigned* bar = b.bar;
    __builtin_amdgcn_s_waitcnt(0);
    unsigned nloc = b.st[0], nx = b.st[1];
    if (nloc == 0u) { xcd_barrier_complete(bar, b.x, nloc, nx); b.st[0] = nloc; b.st[1] = nx; }
    const unsigned old = xb_add(&bar[XB_XSUB(b.x)], 1u);
    const unsigned gen = old / nloc;
    if (old + 1u == (gen + 1u) * nloc) {
      __builtin_amdgcn_fence(__ATOMIC_RELEASE, "agent");
      asm volatile("s_waitcnt vmcnt(0)" ::: "memory");
      const unsigned og = xb_add(&bar[XB_TOP], 1u);
      const unsigned tg = og / nx;
      if (og + 1u == (tg + 1u) * nx) xb_add(&bar[XB_TOPGEN], 1u);
      else XB_SPIN(xb_ld(&bar[XB_TOPGEN]) == tg, bar);
      __builtin_amdgcn_fence(__ATOMIC_ACQUIRE, "agent");
      xb_add(&bar[XB_XGEN(b.x)], 1u);
      asm volatile("s_waitcnt vmcnt(0)" ::: "memory");
    } else {
      XB_SPIN(xb_ld(&bar[XB_XGEN(b.x)]) == gen, bar);
      __builtin_amdgcn_fence(__ATOMIC_ACQUIRE, "agent");
      asm volatile("s_waitcnt vmcnt(0)" ::: "memory");
    }
  }
  __syncthreads();
}

constexpr int DM = 1024;
constexpr int LDX = 1088;
constexpr int SEQ = 4096, PB = 8, SBATCH = 32, DSEQ = 64, PAST = 2048;
constexpr int NP = PB * SEQ;
constexpr int NS = SBATCH * DSEQ;
constexpr int NT = NP + NS;
constexpr float EPS = 1e-6f;
constexpr float LOG2E = 1.4426950408889634f;
constexpr float QS_A = 0.08838834764831845f * LOG2E;
constexpr float QS_B = 0.125f * LOG2E;
constexpr float QS_C = 0.10206207261596575f * LOG2E;
constexpr int CKEYS = PAST + DSEQ;
constexpr int CROUND_B = 16;

constexpr size_t O_Y      = 0;
constexpr size_t O_AKP    = O_Y + (size_t)NT * DM;
constexpr size_t O_AVP    = O_AKP + 8388608;
constexpr size_t O_BKP    = O_AVP + 8388608;
constexpr size_t O_BVP    = O_BKP + 262144;
constexpr size_t O_CKVP   = O_BVP + 262144;
constexpr size_t O_CKRP   = O_CKVP + 8388608;
constexpr size_t O_AKS    = O_CKRP + 1048576;
constexpr size_t O_AVS    = O_AKS + 33554432;
constexpr size_t O_BKS    = O_AVS + 33554432;
constexpr size_t O_BVS    = O_BKS + 1048576;
constexpr size_t O_CKVS   = O_BVS + 1048576;
constexpr size_t O_CKRS   = O_CKVS + 524288;
constexpr size_t O_END    = O_CKRS + 65536;
static_assert(O_END == 132186112, "output size");

constexpr size_t WS_CTL   = 0;
constexpr size_t WS_CTL_BYTES = 16384;
constexpr size_t WS_WAIN  = WS_CTL + WS_CTL_BYTES;
constexpr size_t WS_WAOUT = WS_WAIN + 2 * (size_t)4096 * LDX * 2;
constexpr size_t WS_WBIN  = WS_WAOUT + 2 * (size_t)1024 * LDX * 2;
constexpr size_t WS_WBOUT = WS_WBIN + (size_t)2560 * LDX * 2;
constexpr size_t WS_WCIN  = WS_WBOUT + (size_t)1024 * LDX * 2;
constexpr size_t WS_WCQB  = WS_WCIN + (size_t)2048 * LDX * 2;
constexpr size_t WS_WCKVB = WS_WCQB + 1572864;
constexpr size_t WS_WCOUT = WS_WCKVB + 1048576;
constexpr size_t WS_ROPE  = WS_WCOUT + (size_t)1024 * LDX * 2;
constexpr size_t WS_SG    = WS_ROPE + 524288;
constexpr size_t WS_X     = WS_SG + (size_t)NT * LDX * 2;
constexpr size_t WS_L     = WS_X + (size_t)NT * LDX * 2;
constexpr size_t WS_AQ    = WS_L;
constexpr size_t WS_AKP   = WS_AQ + (size_t)NT * DM * 2;
constexpr size_t WS_AKS   = WS_AKP + (size_t)NP * DM * 2;
constexpr size_t WS_AVTP  = WS_AKS + (size_t)32 * 576 * 1024 * 2;
constexpr size_t WS_AVTS  = WS_AVTP + (size_t)NP * DM * 2;
constexpr size_t WS_AEND  = WS_AVTS + (size_t)32 * 576 * 1024 * 2;
constexpr size_t WS_BQ    = WS_L;
constexpr size_t WS_BKP   = WS_BQ + (size_t)NT * DM * 2;
constexpr size_t WS_BKS   = WS_BKP + (size_t)NP * 256 * 2;
constexpr size_t WS_BVTP  = WS_BKS + (size_t)32 * 192 * 256 * 2;
constexpr size_t WS_BVTS  = WS_BVTP + (size_t)NP * 256 * 2;
constexpr size_t WS_BEND  = WS_BVTS + (size_t)32 * 192 * 256 * 2;
constexpr size_t WS_CZ    = WS_L;
constexpr size_t WS_CQ    = WS_L;
constexpr size_t WS_CCKVP = WS_CZ + (size_t)NT * 800 * 4;
constexpr size_t WS_CKRP  = WS_CCKVP + (size_t)NP * 256 * 2;
constexpr size_t WS_CKRS  = WS_CKRP + (size_t)NP * 32 * 2;
constexpr size_t WS_CKNS  = WS_CKRS + (size_t)32 * CKEYS * 32 * 2;
constexpr size_t WS_CVTS  = WS_CKNS + (size_t)CROUND_B * 16 * CKEYS * 64 * 2;
constexpr size_t WS_CEND  = WS_CVTS + (size_t)CROUND_B * 16 * CKEYS * 64 * 2;
constexpr size_t WS_CQA   = WS_X;
constexpr size_t WS_CCKVS = WS_CQA + (size_t)NT * 512 * 2;
static_assert(WS_CCKVS + (size_t)32 * CKEYS * 256 * 2 <= WS_L, "QA + CKVs must fit in X region");
static_assert((size_t)NT * 1536 * 2 <= (size_t)NT * 800 * 4, "Qc fits in Z region");
constexpr size_t WS_NEED  = WS_AEND > WS_CEND ? (WS_AEND > WS_BEND ? WS_AEND : WS_BEND) : (WS_CEND > WS_BEND ? WS_CEND : WS_BEND);
constexpr size_t O_SCR_KNP = O_AKS + 16777216;
constexpr size_t O_SCR_VTP = O_AVS + 16777216;

struct Params {
  const float* in[29];
  float* out;
  unsigned char* ws;
  int ph_lo, ph_hi;
};

constexpr int NTHR = 512;
constexpr int ATT_SUB_BYTES = 76816;
constexpr int LDS_BYTES = 2 * ATT_SUB_BYTES;
constexpr int C_STR = 132;
static_assert(8 * 16384 <= LDS_BYTES && 2 * 128 * C_STR * 4 <= LDS_BYTES, "lds");

constexpr int HTB = 16384;
DI int lds_byte(int r, int c) { const int st = (r >> 4) * 2 + (c >> 5), rr = r & 15, cc = c & 31, ob = rr * 64 + cc * 2; return st * 1024 + (ob ^ (((ob >> 9) & 1) << 5)); }
DI void stage_rc(int b, int& R, int& C) { const int st = b / 1024, sb = b % 1024, swz = sb ^ (((sb >> 9) & 1) << 5); R = (st >> 1) * 16 + swz / 64; C = (st & 1) * 32 + (swz % 64) / 2; }
DI bool unit_order(long L, int nM, int nN, int& pm, int& pn) {
  const int nwg = nM * nN; if (L >= nwg) return false;
  int wgid = (int)L; { const int q = nwg / 8, r = nwg % 8, xcd = wgid % 8, off = wgid / 8; wgid = (xcd < r ? xcd * (q + 1) : r * (q + 1) + (xcd - r) * q) + off; }
  const int nig = 8 * nN, gid = wgid / nig, fm = gid * 8, gsz = (nM - fm) < 8 ? (nM - fm) : 8;
  pm = fm + ((wgid % nig) % gsz); pn = (wgid % nig) / gsz; return true;
}
DI void gemm256_mainloop(unsigned char* ldsg, const bf16_t* A, long lda, const bf16_t* Bt, long ldb, int K, f32x4 (&acc)[2][2][4][2]) {
  LAS unsigned char* lds = (LAS unsigned char*)ldsg;
  int tid = threadIdx.x; asm volatile("" : "+v"(tid));
  const int wid = __builtin_amdgcn_readfirstlane(tid >> 6), lane = tid & 63, wr = wid >> 2, wc = wid & 3, fr = lane & 15, fq = lane >> 4;
  const int nt = K >> 6;
  unsigned voffA[2], voffB[2];
#pragma unroll
  for (int i = 0; i < 2; ++i) { int R, C; stage_rc(tid * 16 + i * 8192, R, C); voffA[i] = (unsigned)(R * lda + C) * 2u; voffB[i] = (unsigned)(R * ldb + C) * 2u; }
  const size_t kstep = 128, hstepA = (size_t)128 * lda * 2, hstepB = (size_t)128 * ldb * 2;
  const unsigned ldsw = (unsigned)wid * 1024u;
  const int aoff = lds_byte(wr * 64 + fr, fq * 8), boff = lds_byte(wc * 32 + fr, fq * 8);
  const char* cA = (const char*)A; const char* cB = (const char*)Bt;
#define G_SA(b, h) (((b) * 2 + (h)) * HTB)
#define G_SB(b, h) ((4 + (b) * 2 + (h)) * HTB)
#define G_STAGE(bufoff, gbase, voff) do { _Pragma("unroll") for (int _i = 0; _i < 2; ++_i) \
    __builtin_amdgcn_global_load_lds((const unsigned*)((const char*)(gbase) + (voff)[_i]), (LAS unsigned*)(lds + (bufoff) + ldsw + _i * 8192), 16, 0, 0); } while (0)
#define G_LDA(dst, b, h) do { _Pragma("unroll") for (int m = 0; m < 4; ++m) _Pragma("unroll") for (int k = 0; k < 2; ++k) dst[m][k] = *(const LAS bf16x8*)(lds + G_SA(b, h) + aoff + m * 2048 + k * 1024); } while (0)
#define G_LDB(dst, b, h) do { _Pragma("unroll") for (int n = 0; n < 2; ++n) _Pragma("unroll") for (int k = 0; k < 2; ++k) dst[n][k] = *(const LAS bf16x8*)(lds + G_SB(b, h) + boff + n * 2048 + k * 1024); } while (0)
#define G_MMA(ai, bj, At, Bt_) do { __builtin_amdgcn_s_setprio(1); _Pragma("unroll") for (int m = 0; m < 4; ++m) _Pragma("unroll") for (int n = 0; n < 2; ++n) _Pragma("unroll") for (int k = 0; k < 2; ++k) \
    acc[ai][bj][m][n] = __builtin_amdgcn_mfma_f32_16x16x32_bf16(Bt_[n][k], At[m][k], acc[ai][bj][m][n], 0, 0, 0); __builtin_amdgcn_s_setprio(0); } while (0)
#define G_WAIT_V(n) asm volatile("s_waitcnt vmcnt(" #n ")" ::: "memory")
#define G_WAIT_L(n) asm volatile("s_waitcnt lgkmcnt(" #n ")" ::: "memory")
#define G_BAR __builtin_amdgcn_s_barrier()
#define G_SCHED __builtin_amdgcn_sched_barrier(0)
#pragma unroll
  for (int a = 0; a < 2; ++a)
#pragma unroll
    for (int b = 0; b < 2; ++b)
#pragma unroll
      for (int m = 0; m < 4; ++m)
#pragma unroll
        for (int n = 0; n < 2; ++n) acc[a][b][m][n] = (f32x4){0.f, 0.f, 0.f, 0.f};
  bf16x8 At[4][2], B0[2][2], B1[2][2];
  G_STAGE(G_SB(0, 0), cB, voffB); G_STAGE(G_SA(0, 0), cA, voffA); G_STAGE(G_SB(0, 1), cB + hstepB, voffB); G_STAGE(G_SA(0, 1), cA + hstepA, voffA);
  if (wr == 1) G_BAR;
  G_WAIT_V(4); G_BAR;
  G_STAGE(G_SB(1, 0), cB + kstep, voffB); G_STAGE(G_SA(1, 0), cA + kstep, voffA); G_STAGE(G_SB(1, 1), cB + hstepB + kstep, voffB);
  G_WAIT_V(6); G_BAR;
  for (int t = 0; t < nt - 2; t += 2) {
    const char* a1 = cA + (size_t)(t + 1) * kstep;
    const char* a2 = cA + (size_t)(t + 2) * kstep; const char* b2 = cB + (size_t)(t + 2) * kstep;
    const char* a3 = a2 + kstep; const char* b3 = b2 + kstep;
    G_LDB(B0, 0, 0); G_SCHED; G_LDA(At, 0, 0); G_STAGE(G_SA(1, 1), a1 + hstepA, voffA);
    G_WAIT_L(8); G_BAR; G_WAIT_L(0); G_MMA(0, 0, At, B0); G_BAR; G_SCHED;
    G_LDB(B1, 0, 1); G_STAGE(G_SB(0, 0), b2, voffB);
    G_BAR; G_WAIT_L(0); G_MMA(0, 1, At, B1); G_BAR;
    G_LDA(At, 0, 1); G_STAGE(G_SA(0, 0), a2, voffA);
    G_BAR; G_WAIT_L(0); G_MMA(1, 0, At, B0); G_BAR; G_SCHED;
    G_STAGE(G_SB(0, 1), b2 + hstepB, voffB);
    G_WAIT_V(6); G_BAR; G_MMA(1, 1, At, B1); G_BAR;
    G_LDB(B0, 1, 0); G_SCHED; G_LDA(At, 1, 0); G_STAGE(G_SA(0, 1), a2 + hstepA, voffA);
    G_WAIT_L(8); G_BAR; G_WAIT_L(0); G_MMA(0, 0, At, B0); G_BAR; G_SCHED;
    G_LDB(B1, 1, 1); G_STAGE(G_SB(1, 0), b3, voffB);
    G_BAR; G_WAIT_L(0); G_MMA(0, 1, At, B1); G_BAR;
    G_LDA(At, 1, 1); G_STAGE(G_SA(1, 0), a3, voffA);
    G_BAR; G_WAIT_L(0); G_MMA(1, 0, At, B0); G_BAR; G_SCHED;
    G_STAGE(G_SB(1, 1), b3 + hstepB, voffB);
    G_WAIT_V(6); G_BAR; G_MMA(1, 1, At, B1); G_BAR;
  }
  { G_LDB(B0, 0, 0); G_LDA(At, 0, 0); G_STAGE(G_SA(1, 1), cA + (size_t)(nt - 1) * kstep + hstepA, voffA);
    G_BAR; G_WAIT_L(0); G_MMA(0, 0, At, B0); G_BAR;
    G_LDB(B1, 0, 1); G_BAR; G_WAIT_L(0); G_MMA(0, 1, At, B1); G_BAR;
    G_LDA(At, 0, 1); G_WAIT_V(4); G_BAR; G_WAIT_L(0); G_MMA(1, 0, At, B0); G_MMA(1, 1, At, B1); G_BAR; }
  { G_LDB(B0, 1, 0); G_LDA(At, 1, 0); G_WAIT_V(2); G_BAR; G_WAIT_L(0); G_MMA(0, 0, At, B0); G_BAR;
    G_LDB(B1, 1, 1); G_WAIT_V(0); G_BAR; G_WAIT_L(0); G_MMA(0, 1, At, B1); G_BAR;
    G_LDA(At, 1, 1); G_BAR; G_WAIT_L(0); G_MMA(1, 0, At, B0); G_MMA(1, 1, At, B1); G_BAR; }
  if (wr == 0) G_BAR;
#undef G_SA
#undef G_SB
#undef G_STAGE
#undef G_LDA
#undef G_LDB
#undef G_MMA
#undef G_WAIT_V
#undef G_WAIT_L
#undef G_BAR
#undef G_SCHED
}
constexpr int CS_FLOATS = 128 * C_STR;
template <class Epi>
DI void gemm256_unit(unsigned char* lds, const bf16_t* A, long lda, const bf16_t* Bt, long ldb, int K, int m0, int nt0, const Epi& epi) {
  f32x4 acc[2][2][4][2];
  gemm256_mainloop(lds, A, lda, Bt, ldb, K, acc);
  int tid = threadIdx.x; asm volatile("" : "+v"(tid));
  const int wid = tid >> 6, lane = tid & 63, wr = wid >> 2, wc = wid & 3, fr = lane & 15, fq = lane >> 4;
  float* Cs = (float*)lds;
#pragma unroll
  for (int ai = 0; ai < 2; ++ai) {
#pragma unroll
    for (int bj = 0; bj < 2; ++bj)
#pragma unroll
      for (int m = 0; m < 4; ++m)
#pragma unroll
        for (int n = 0; n < 2; ++n)
          *(f32x4*)(Cs + bj * CS_FLOATS + (wr * 64 + m * 16 + fr) * C_STR + wc * 32 + n * 16 + 4 * fq) = acc[ai][bj][m][n];
    __syncthreads();
    const int sub = tid >> 8;
    epi((const float*)(Cs + sub * CS_FLOATS), m0 + ai * 128, nt0 + sub, tid & 255);
    __syncthreads();
  }
}
template <class Epi>
DI void gemm_units(unsigned char* lds, const bf16_t* A, long lda, const bf16_t* Bt, long ldb, int K, int nM, int nN, int shift, const Epi& epi) {
  const int G = gridDim.x; int c = (int)blockIdx.x - shift; if (c < 0) c += G;
  for (int i = 0; ; ++i) {
    int pm, pn;
    if (!unit_order((long)i * G + c, nM, nN, pm, pn)) break;
    gemm256_unit(lds, A + (size_t)pm * 256 * lda, lda, Bt + (size_t)pn * 256 * ldb, ldb, K, pm * 256, pn * 2, epi);
  }
}

DI float row_sumsq(const float* rp, int n4) {
  float ss = 0.f;
  for (int j = 0; j < n4; ++j) { f32x4 v = *(const f32x4*)(rp + 4 * j); ss += v[0] * v[0] + v[1] * v[1] + v[2] * v[2] + v[3] * v[3]; }
  return ss;
}
DI void norm_store64(const float* rp, const float* __restrict__ g, float sc, bf16_t* dst, float fsc, float* fdst) {
#pragma unroll
  for (int j = 0; j < 8; ++j) {
    f32x4 v0 = *(const f32x4*)(rp + 8 * j), v1 = *(const f32x4*)(rp + 8 * j + 4);
    f32x4 g0 = *(const f32x4*)(g + 8 * j), g1 = *(const f32x4*)(g + 8 * j + 4);
    f32x4 x0 = v0 * g0, x1 = v1 * g1;
    u32x4 o = {pk2(x0[0] * sc, x0[1] * sc), pk2(x0[2] * sc, x0[3] * sc), pk2(x1[0] * sc, x1[1] * sc), pk2(x1[2] * sc, x1[3] * sc)};
    *(u32x4*)(dst + 8 * j) = o;
    if (fdst) { *(f32x4*)(fdst + 8 * j) = x0 * fsc; *(f32x4*)(fdst + 8 * j + 4) = x1 * fsc; }
  }
}
DI void raw_store64_f32(const float* rp, float* fdst) {
#pragma unroll
  for (int j = 0; j < 16; ++j) *(f32x4*)(fdst + 4 * j) = *(const f32x4*)(rp + 4 * j);
}
DI void raw_store64_bf16(const float* rp, bf16_t* dst) {
#pragma unroll
  for (int j = 0; j < 8; ++j) {
    f32x4 v0 = *(const f32x4*)(rp + 8 * j), v1 = *(const f32x4*)(rp + 8 * j + 4);
    u32x4 o = {pk2(v0[0], v0[1]), pk2(v0[2], v0[3]), pk2(v1[0], v1[1]), pk2(v1[2], v1[3])};
    *(u32x4*)(dst + 8 * j) = o;
  }
}
DI void silu_store64(const float* rp, bf16_t* dst) {
#pragma unroll
  for (int j = 0; j < 8; ++j) {
    f32x4 v0 = *(const f32x4*)(rp + 8 * j), v1 = *(const f32x4*)(rp + 8 * j + 4);
    u32x4 o = {pk2(silu(v0[0]), silu(v0[1])), pk2(silu(v0[2]), silu(v0[3])), pk2(silu(v1[0]), silu(v1[1])), pk2(silu(v1[2]), silu(v1[3]))};
    *(u32x4*)(dst + 8 * j) = o;
  }
}
DI void tr_store64(const float* Cs, int col, int rh, bf16_t* dst) {
#pragma unroll
  for (int g = 0; g < 8; ++g) {
    const float* p = Cs + (rh * 64 + g * 8) * C_STR + col;
    u32x4 o = {pk2(p[0], p[C_STR]), pk2(p[2 * C_STR], p[3 * C_STR]), pk2(p[4 * C_STR], p[5 * C_STR]), pk2(p[6 * C_STR], p[7 * C_STR])};
    *(u32x4*)(dst + g * 8) = o;
  }
}


template <int LANES> DI float seg_sum(float v) {
#pragma unroll
  for (int o = 1; o < LANES; o <<= 1) v += __shfl_xor(v, o);
  return v;
}
template <int MODE, int SEG, class DB, class DF>
DI void epi_rows(const float* Cs, int t, const float* __restrict__ gain, float scale, DB dstb, DF dstf) {
  const int rl = t >> 4, c0 = (t & 15) * 8;
  f32x4 g0 = {1.f, 1.f, 1.f, 1.f}, g1 = g0;
  if (MODE == 1) { g0 = *(const f32x4*)(gain + (c0 & (SEG - 1))); g1 = *(const f32x4*)(gain + (c0 & (SEG - 1)) + 4); }
#pragma unroll 2
  for (int p = 0; p < 8; ++p) {
    const int row = p * 16 + rl;
    f32x4 a = *(const f32x4*)(Cs + row * C_STR + c0), b = *(const f32x4*)(Cs + row * C_STR + c0 + 4);
    float sc = 1.f;
    if (MODE == 1) {
      float ss = a[0] * a[0] + a[1] * a[1] + a[2] * a[2] + a[3] * a[3] + b[0] * b[0] + b[1] * b[1] + b[2] * b[2] + b[3] * b[3];
      ss = seg_sum<SEG / 8>(ss);
      const float rinv = rsqrtf(ss * (1.f / SEG) + EPS);
      a = a * g0 * rinv; b = b * g1 * rinv; sc = scale;
    } else if (MODE == 2) {
#pragma unroll
      for (int k = 0; k < 4; ++k) { a[k] = silu(a[k]); b[k] = silu(b[k]); }
    }
    bf16_t* db = dstb(row, c0);
    if (db) { u32x4 o = {pk2(a[0] * sc, a[1] * sc), pk2(a[2] * sc, a[3] * sc), pk2(b[0] * sc, b[1] * sc), pk2(b[2] * sc, b[3] * sc)}; *(u32x4*)db = o; }
    float* df = dstf(row, c0);
    if (df) { *(f32x4*)df = a; *(f32x4*)(df + 4) = b; }
  }
}
struct NoB { DI bf16_t* operator()(int, int) const { return nullptr; } };
struct NoF { DI float* operator()(int, int) const { return nullptr; } };

struct Ctx {
  const float* const* in;
  float* out;
  unsigned char* ws;
  DI const float* xin_row(int layer, int row) const {
    if (layer == 0) return row < NP ? in[0] + (size_t)row * DM : in[1] + (size_t)(row - NP) * DM;
    return out + (size_t)row * DM;
  }
  template <class T> DI T* wsp(size_t off) const { return (T*)(ws + off); }
};

template <class Perm>
DI void wt_job(const float* __restrict__ W, int K, int N, bf16_t* __restrict__ Wt, int ldw, int Np, Perm perm, long gtid, long gsz) {
  const long items = (long)Np * (K / 8);
  for (long idx = gtid; idx < items; idx += gsz) {
    const int np = (int)(idx % Np), kg = (int)(idx / Np);
    const int n = perm(np);
    u32x4 o = {0u, 0u, 0u, 0u};
    if (n >= 0) {
      const float* p = W + (size_t)(kg * 8) * N + n;
      o = (u32x4){pk2(p[0], p[(size_t)N]), pk2(p[(size_t)2 * N], p[(size_t)3 * N]), pk2(p[(size_t)4 * N], p[(size_t)5 * N]), pk2(p[(size_t)6 * N], p[(size_t)7 * N])};
    }
    *(u32x4*)(Wt + (size_t)np * ldw + kg * 8) = o;
  }
}
__constant__ float ROPE_INV[16] = {1.000000000e+00f, 5.623413324e-01f, 3.162277639e-01f, 1.778279394e-01f, 1.000000015e-01f, 5.623413250e-02f,
                                   3.162277490e-02f, 1.778279431e-02f, 9.999999776e-03f, 5.623413250e-03f, 3.162277630e-03f, 1.778279431e-03f,
                                   1.000000047e-03f, 5.623413017e-04f, 3.162277571e-04f, 1.778279402e-04f};
DI void phase_prep(const Ctx& c) {
  const long gtid = (long)blockIdx.x * NTHR + threadIdx.x, gsz = (long)gridDim.x * NTHR;
  auto ident = [](int n) { return n; };
  for (int j = 0; j < 2; ++j) {
    wt_job(c.in[9] + (size_t)j * 1024 * 4096, 1024, 4096, c.wsp<bf16_t>(WS_WAIN) + (size_t)j * 4096 * LDX, LDX, 4096, ident, gtid, gsz);
    wt_job(c.in[13] + (size_t)j * 1024 * 1024, 1024, 1024, c.wsp<bf16_t>(WS_WAOUT) + (size_t)j * 1024 * LDX, LDX, 1024, ident, gtid, gsz);
  }
  wt_job(c.in[15], 1024, 2560, c.wsp<bf16_t>(WS_WBIN), LDX, 2560, ident, gtid, gsz);
  wt_job(c.in[19], 1024, 1024, c.wsp<bf16_t>(WS_WBOUT), LDX, 1024, ident, gtid, gsz);
  wt_job(c.in[21], 1024, 1824, c.wsp<bf16_t>(WS_WCIN), LDX, 2048, [](int n) { return n < 1024 ? 800 + n : (n < 1824 ? n - 1024 : -1); }, gtid, gsz);
  wt_job(c.in[23], 512, 1536, c.wsp<bf16_t>(WS_WCQB), 512, 1536,
         [](int n) { return n < 1024 ? (n >> 6) * 96 + (n & 63) : ((n - 1024) >> 5) * 96 + 64 + ((n - 1024) & 31); }, gtid, gsz);
  wt_job(c.in[25], 256, 2048, c.wsp<bf16_t>(WS_WCKVB), 256, 2048,
         [](int n) { return n < 1024 ? (n >> 6) * 128 + (n & 63) : ((n - 1024) >> 6) * 128 + 64 + ((n - 1024) & 63); }, gtid, gsz);
  wt_job(c.in[28], 1024, 1024, c.wsp<bf16_t>(WS_WCOUT), LDX, 1024, ident, gtid, gsz);
  float* rope = c.wsp<float>(WS_ROPE);
  for (long idx = gtid; idx < 4096 * 16; idx += gsz) {
    const int pos = (int)(idx >> 4), i = (int)(idx & 15);
    const float ang = (float)pos * ROPE_INV[i];
    const double rev = (double)ang * 0.15915494309189533577;
    const float fr = (float)(rev - floor(rev));
    rope[idx * 2] = __builtin_amdgcn_cosf(fr);
    rope[idx * 2 + 1] = __builtin_amdgcn_sinf(fr);
  }
}

DI void phase_xn(const Ctx& c, int layer, const float* __restrict__ g) {
  const int lane = threadIdx.x & 63;
  const int gw = blockIdx.x * (NTHR / 64) + (threadIdx.x >> 6), nw = gridDim.x * (NTHR / 64);
  bf16_t* xn = c.wsp<bf16_t>(WS_X);
  for (int row = gw; row < NT; row += nw) {
    const float* x = c.xin_row(layer, row);
    f32x4 v[4];
    float ss = 0.f;
#pragma unroll
    for (int i = 0; i < 2; ++i) {
      v[2 * i] = *(const f32x4*)(x + i * 512 + lane * 8);
      v[2 * i + 1] = *(const f32x4*)(x + i * 512 + lane * 8 + 4);
      ss += v[2 * i][0] * v[2 * i][0] + v[2 * i][1] * v[2 * i][1] + v[2 * i][2] * v[2 * i][2] + v[2 * i][3] * v[2 * i][3];
      ss += v[2 * i + 1][0] * v[2 * i + 1][0] + v[2 * i + 1][1] * v[2 * i + 1][1] + v[2 * i + 1][2] * v[2 * i + 1][2] + v[2 * i + 1][3] * v[2 * i + 1][3];
    }
    ss = wave_sum(ss);
    const float rinv = rsqrtf(ss * (1.f / 1024.f) + EPS);
#pragma unroll
    for (int i = 0; i < 2; ++i) {
      f32x4 g0 = *(const f32x4*)(g + i * 512 + lane * 8), g1 = *(const f32x4*)(g + i * 512 + lane * 8 + 4);
      f32x4 a = v[2 * i] * g0 * rinv, b = v[2 * i + 1] * g1 * rinv;
      u32x4 o = {pk2(a[0], a[1]), pk2(a[2], a[3]), pk2(b[0], b[1]), pk2(b[2], b[3])};
      *(u32x4*)(xn + (size_t)row * LDX + i * 512 + lane * 8) = o;
    }
  }
}

DI void conv_cache(const float* __restrict__ ck, const float* __restrict__ cv, bf16_t* __restrict__ Ks, bf16_t* __restrict__ Vts,
                   float* __restrict__ ok, float* __restrict__ ov, int L, int H, int Dh) {
  const long gtid = (long)blockIdx.x * NTHR + threadIdx.x, gsz = (long)gridDim.x * NTHR;
  const int W = H * Dh, W8 = W / 8, LT = L + 64;
  const long nk = (long)SBATCH * L * W8;
  for (long idx = gtid; idx < nk; idx += gsz) {
    const int c8 = (int)(idx % W8); const long br = idx / W8; const int row = (int)(br % L), b = (int)(br / L);
    const float* p = ck + ((size_t)b * L + row) * W + c8 * 8;
    f32x4 a = *(const f32x4*)p, d = *(const f32x4*)(p + 4);
    u32x4 o = {pk2(a[0], a[1]), pk2(a[2], a[3]), pk2(d[0], d[1]), pk2(d[2], d[3])};
    *(u32x4*)(Ks + ((size_t)b * LT + row) * W + c8 * 8) = o;
    if (row >= 64) {
      float* q = ok + ((size_t)b * L + row - 64) * W + c8 * 8;
      *(f32x4*)q = a; *(f32x4*)(q + 4) = d;
    }
    const float* pv = cv + ((size_t)b * L + row) * W + c8 * 8;
    f32x4 va = *(const f32x4*)pv, vd = *(const f32x4*)(pv + 4);
    u32x4 vo = {pk2(va[0], va[1]), pk2(va[2], va[3]), pk2(vd[0], vd[1]), pk2(vd[2], vd[3])};
    *(u32x4*)(Vts + ((size_t)b * LT + row) * W + c8 * 8) = vo;
    if (row >= 64) {
      float* qv = ov + ((size_t)b * L + row - 64) * W + c8 * 8;
      *(f32x4*)qv = va; *(f32x4*)(qv + 4) = vd;
    }
  }
}
DI void conv_cache_c(const Ctx& c) {
  const long gtid = (long)blockIdx.x * NTHR + threadIdx.x, gsz = (long)gridDim.x * NTHR;
  const float* ckv = c.in[6]; const float* ckr = c.in[7];
  bf16_t* CKVs = c.wsp<bf16_t>(WS_CCKVS); bf16_t* KRs = c.wsp<bf16_t>(WS_CKRS);
  const long n1 = (long)SBATCH * PAST * 32;
  for (long idx = gtid; idx < n1; idx += gsz) {
    const int c8 = (int)(idx & 31); const long br = idx >> 5; const int row = (int)(br % PAST), b = (int)(br / PAST);
    const float* p = ckv + ((size_t)b * PAST + row) * 256 + c8 * 8;
    f32x4 a = *(const f32x4*)p, d = *(const f32x4*)(p + 4);
    u32x4 o = {pk2(a[0], a[1]), pk2(a[2], a[3]), pk2(d[0], d[1]), pk2(d[2], d[3])};
    *(u32x4*)(CKVs + ((size_t)b * CKEYS + row) * 256 + c8 * 8) = o;
  }
  const long n2 = (long)SBATCH * PAST * 4;
  for (long idx = gtid; idx < n2; idx += gsz) {
    const int c8 = (int)(idx & 3); const long br = idx >> 2; const int row = (int)(br % PAST), b = (int)(br / PAST);
    const float* p = ckr + ((size_t)b * PAST + row) * 32 + c8 * 8;
    f32x4 a = *(const f32x4*)p, d = *(const f32x4*)(p + 4);
    u32x4 o = {pk2(a[0], a[1]), pk2(a[2], a[3]), pk2(d[0], d[1]), pk2(d[2], d[3])};
    *(u32x4*)(KRs + ((size_t)b * CKEYS + row) * 32 + c8 * 8) = o;
  }
}

DI void phase_gemm_a_in(const Ctx& c, unsigned char* lds, int j) {
  const bf16_t* XN = c.wsp<bf16_t>(WS_X);
  const bf16_t* Wt = c.wsp<bf16_t>(WS_WAIN) + (size_t)j * 4096 * LDX;
  auto epi = [&](const float* Cs, int m0, int nt, int t) {
    const float* qg = c.in[10] + j * 128; const float* kg = c.in[11] + j * 128;
    bf16_t* Q = c.wsp<bf16_t>(WS_AQ); bf16_t* Kp = c.wsp<bf16_t>(WS_AKP); bf16_t* Ks = c.wsp<bf16_t>(WS_AKS);
    bf16_t* Vtp = c.wsp<bf16_t>(WS_AVTP); bf16_t* Vts = c.wsp<bf16_t>(WS_AVTS); bf16_t* SG = c.wsp<bf16_t>(WS_SG);
    const int type = nt >> 3, head = nt & 7;
    const bool prompt = m0 < NP;
    float* out = c.out;
    auto cache_f32 = [&](size_t obase_p, size_t obase_s, int row, int c0) -> float* {
      const int grow = m0 + row;
      if (prompt) { const int b = grow >> 12, sq = grow & 4095; if (sq < SEQ - 512) return nullptr;
        return out + obase_p + ((((size_t)j * PB + b) * 512 + (sq - (SEQ - 512))) * 8 + head) * 128 + c0; }
      const int sr = grow - NP, b = sr >> 6, tt = sr & 63;
      return out + obase_s + ((((size_t)j * SBATCH + b) * 512 + 448 + tt) * 8 + head) * 128 + c0;
    };
    auto kv_bf16 = [&](bf16_t* P_, bf16_t* S_, int row, int c0) -> bf16_t* {
      const int grow = m0 + row;
      if (prompt) return P_ + (size_t)grow * DM + head * 128 + c0;
      const int sr = grow - NP, b = sr >> 6, tt = sr & 63;
      return S_ + ((size_t)b * 576 + 512 + tt) * DM + head * 128 + c0;
    };
    if (type == 0) {
      epi_rows<1, 128>(Cs, t, qg, QS_A, [&](int row, int c0) { return Q + (size_t)(m0 + row) * DM + head * 128 + c0; }, NoF());
    } else if (type == 1) {
      epi_rows<1, 128>(Cs, t, kg, 1.f, [&](int row, int c0) { return kv_bf16(Kp, Ks, row, c0); }, [&](int row, int c0) { return cache_f32(O_AKP, O_AKS, row, c0); });
    } else if (type == 2) {
      epi_rows<0, 128>(Cs, t, nullptr, 1.f, [&](int row, int c0) { return kv_bf16(Vtp, Vts, row, c0); }, [&](int row, int c0) { return cache_f32(O_AVP, O_AVS, row, c0); });
    } else {
      epi_rows<2, 128>(Cs, t, nullptr, 1.f, [&](int row, int c0) { return SG + (size_t)(m0 + row) * LDX + head * 128 + c0; }, NoF());
    }
  };
  gemm_units(lds, XN, LDX, Wt, LDX, DM, NT / 256, 16, 0, epi);
}

DI void phase_gemm_b_in(const Ctx& c, unsigned char* lds) {
  const bf16_t* XN = c.wsp<bf16_t>(WS_X);
  const bf16_t* Wt = c.wsp<bf16_t>(WS_WBIN);
  auto epi = [&](const float* Cs, int m0, int nt, int t) {
    const float* qg = c.in[16]; const float* kg = c.in[17];
    bf16_t* Q = c.wsp<bf16_t>(WS_BQ); bf16_t* Kp = c.wsp<bf16_t>(WS_BKP); bf16_t* Ks = c.wsp<bf16_t>(WS_BKS);
    bf16_t* Vtp = c.wsp<bf16_t>(WS_BVTP); bf16_t* Vts = c.wsp<bf16_t>(WS_BVTS); bf16_t* SG = c.wsp<bf16_t>(WS_SG);
    const bool prompt = m0 < NP;
    float* out = c.out;
    auto cache_f32 = [&](size_t obase_p, size_t obase_s, int hk0, int row, int c0) -> float* {
      const int grow = m0 + row, hk = hk0 + (c0 >> 6), cc = c0 & 63;
      if (prompt) { const int b = grow >> 12, sq = grow & 4095; if (sq < SEQ - 128) return nullptr;
        return out + obase_p + (((size_t)b * 128 + (sq - (SEQ - 128))) * 4 + hk) * 64 + cc; }
      const int sr = grow - NP, b = sr >> 6, tt = sr & 63;
      return out + obase_s + (((size_t)b * 128 + 64 + tt) * 4 + hk) * 64 + cc;
    };
    auto kv_bf16 = [&](bf16_t* P_, bf16_t* S_, int hk0, int row, int c0) -> bf16_t* {
      const int grow = m0 + row;
      if (prompt) return P_ + (size_t)grow * 256 + hk0 * 64 + c0;
      const int sr = grow - NP, b = sr >> 6, tt = sr & 63;
      return S_ + ((size_t)b * 192 + 128 + tt) * 256 + hk0 * 64 + c0;
    };
    if (nt < 8) {
      epi_rows<1, 64>(Cs, t, qg, QS_B, [&](int row, int c0) { return Q + (size_t)(m0 + row) * DM + nt * 128 + c0; }, NoF());
    } else if (nt < 10) {
      const int hk0 = (nt - 8) * 2;
      epi_rows<1, 64>(Cs, t, kg, 1.f, [&](int row, int c0) { return kv_bf16(Kp, Ks, hk0, row, c0); }, [&](int row, int c0) { return cache_f32(O_BKP, O_BKS, hk0, row, c0); });
    } else if (nt < 12) {
      const int hk0 = (nt - 10) * 2;
      epi_rows<0, 64>(Cs, t, nullptr, 1.f, [&](int row, int c0) { return kv_bf16(Vtp, Vts, hk0, row, c0); }, [&](int row, int c0) { return cache_f32(O_BVP, O_BVS, hk0, row, c0); });
    } else {
      epi_rows<2, 64>(Cs, t, nullptr, 1.f, [&](int row, int c0) { return SG + (size_t)(m0 + row) * LDX + (nt - 12) * 128 + c0; }, NoF());
    }
  };
  gemm_units(lds, XN, LDX, Wt, LDX, DM, NT / 256, 10, 0, epi);
}

DI void phase_gemm_c_in(const Ctx& c, unsigned char* lds) {
  const bf16_t* XN = c.wsp<bf16_t>(WS_X);
  const bf16_t* Wt = c.wsp<bf16_t>(WS_WCIN);
  auto epi = [&](const float* Cs, int m0, int nt, int t) {
    bf16_t* SG = c.wsp<bf16_t>(WS_SG); float* Z = c.wsp<float>(WS_CZ);
    if (nt < 8) {
      epi_rows<2, 128>(Cs, t, nullptr, 1.f, [&](int row, int c0) { return SG + (size_t)(m0 + row) * LDX + nt * 128 + c0; }, NoF());
    } else {
      const int zc0 = (nt - 8) * 128;
      epi_rows<0, 128>(Cs, t, nullptr, 1.f, NoB(), [&](int row, int c0) -> float* { return (zc0 + c0 < 800) ? Z + (size_t)(m0 + row) * 800 + zc0 + c0 : nullptr; });
    }
  };
  gemm_units(lds, XN, LDX, Wt, LDX, DM, NT / 256, 8, 0, epi);
}

DI void phase_c_norm(const Ctx& c) {
  const int lane = threadIdx.x & 63;
  const int gw = blockIdx.x * (NTHR / 64) + (threadIdx.x >> 6), nw = gridDim.x * (NTHR / 64);
  const float* Z = c.wsp<float>(WS_CZ);
  bf16_t* QA = c.wsp<bf16_t>(WS_CQA);
  bf16_t* CKVp = c.wsp<bf16_t>(WS_CCKVP); bf16_t* CKVs = c.wsp<bf16_t>(WS_CCKVS);
  bf16_t* KRp = c.wsp<bf16_t>(WS_CKRP); bf16_t* KRs = c.wsp<bf16_t>(WS_CKRS);
  const float* qag = c.in[22]; const float* kvag = c.in[24]; const float* ckg = c.in[27];
  const float* rope = c.wsp<float>(WS_ROPE);
  for (int row = gw; row < NT; row += nw) {
    const float* z = Z + (size_t)row * 800;
    const bool prompt = row < NP;
    int b, s, pos;
    if (prompt) { b = row >> 12; s = row & 4095; pos = s; } else { b = (row - NP) >> 6; s = (row - NP) & 63; pos = PAST + s; }
    {
      f32x4 a = *(const f32x4*)(z + lane * 8), d = *(const f32x4*)(z + lane * 8 + 4);
      float ss = a[0] * a[0] + a[1] * a[1] + a[2] * a[2] + a[3] * a[3] + d[0] * d[0] + d[1] * d[1] + d[2] * d[2] + d[3] * d[3];
      ss = wave_sum(ss);
      const float rinv = rsqrtf(ss * (1.f / 512.f) + EPS);
      f32x4 g0 = *(const f32x4*)(qag + lane * 8), g1 = *(const f32x4*)(qag + lane * 8 + 4);
      a = a * g0 * rinv; d = d * g1 * rinv;
      u32x4 o = {pk2(a[0], a[1]), pk2(a[2], a[3]), pk2(d[0], d[1]), pk2(d[2], d[3])};
      *(u32x4*)(QA + (size_t)row * 512 + lane * 8) = o;
    }
    {
      f32x4 a = *(const f32x4*)(z + 512 + lane * 4);
      float ss = a[0] * a[0] + a[1] * a[1] + a[2] * a[2] + a[3] * a[3];
      ss = wave_sum(ss);
      const float rinv = rsqrtf(ss * (1.f / 256.f) + EPS);
      f32x4 g0 = *(const f32x4*)(kvag + lane * 4);
      a = a * g0 * rinv;
      u32x2 o = {pk2(a[0], a[1]), pk2(a[2], a[3])};
      if (prompt) {
        *(f32x4*)(c.out + O_CKVP + (size_t)row * 256 + lane * 4) = a;
        *(u32x2*)(CKVp + (size_t)row * 256 + lane * 4) = o;
      } else {
        *(f32x4*)(c.out + O_CKVS + ((size_t)b * 64 + s) * 256 + lane * 4) = a;
        *(u32x2*)(CKVs + ((size_t)b * CKEYS + PAST + s) * 256 + lane * 4) = o;
      }
    }
    {
      float v = lane < 32 ? z[768 + lane] : 0.f;
      float ss = wave_sum(v * v);
      const float rinv = rsqrtf(ss * (1.f / 32.f) + EPS);
      const float xn = v * rinv * ckg[64 + (lane & 31)];
      const float other = __shfl_xor(xn, 16);
      const int i = lane & 15;
      const float cs = rope[((size_t)pos * 16 + i) * 2], sn = rope[((size_t)pos * 16 + i) * 2 + 1];
      const float o = (lane & 16) ? (other * sn + xn * cs) : (xn * cs - other * sn);
      if (lane < 32) {
        const unsigned ob = pk2(o, 0.f) & 0xffffu;
        if (prompt) {
          c.out[O_CKRP + (size_t)row * 32 + lane] = o;
          KRp[(size_t)row * 32 + lane] = (bf16_t)ob;
        } else {
          c.out[O_CKRS + ((size_t)b * 64 + s) * 32 + lane] = o;
          KRs[((size_t)b * CKEYS + PAST + s) * 32 + lane] = (bf16_t)ob;
        }
      }
    }
  }
}

DI void c_q_gemm(const Ctx& c, unsigned char* lds, int shift) {
  const bf16_t* QA = c.wsp<bf16_t>(WS_CQA);
  const bf16_t* Wt = c.wsp<bf16_t>(WS_WCQB);
  auto epi = [&](const float* Cs, int m0, int nt, int t) {
  bf16_t* Qc = c.wsp<bf16_t>(WS_CQ);
  const float* cqg = c.in[26];
  const float* rope = c.wsp<float>(WS_ROPE);
  if (nt < 8) {
    epi_rows<1, 64>(Cs, t, cqg, QS_C, [&](int row, int c0) { return Qc + (size_t)(m0 + row) * 1536 + (nt * 2 + (c0 >> 6)) * 96 + (c0 & 63); }, NoF());
  } else {
    const int rl = t >> 4, c0 = (t & 15) * 8, hq = c0 >> 5, ci = c0 & 31, i0 = ci & 15;
    const bool isx2 = ci >= 16;
    const f32x4 g0 = *(const f32x4*)(cqg + 64 + ci), g1 = *(const f32x4*)(cqg + 64 + ci + 4);
#pragma unroll 2
    for (int p = 0; p < 8; ++p) {
      const int row = p * 16 + rl, grow = m0 + row;
      f32x4 a = *(const f32x4*)(Cs + row * C_STR + c0), b = *(const f32x4*)(Cs + row * C_STR + c0 + 4);
      float ss = a[0] * a[0] + a[1] * a[1] + a[2] * a[2] + a[3] * a[3] + b[0] * b[0] + b[1] * b[1] + b[2] * b[2] + b[3] * b[3];
      ss = seg_sum<4>(ss);
      const float rinv = rsqrtf(ss * (1.f / 32.f) + EPS);
      a = a * g0 * rinv; b = b * g1 * rinv;
      const int pos = grow < NP ? (grow & 4095) : PAST + ((grow - NP) & 63);
      const float* rt = rope + (size_t)pos * 32 + 2 * i0;
      const f32x4 cs0 = *(const f32x4*)rt, cs1 = *(const f32x4*)(rt + 4), cs2 = *(const f32x4*)(rt + 8), cs3 = *(const f32x4*)(rt + 12);
      const float cv[8] = {cs0[0], cs0[2], cs1[0], cs1[2], cs2[0], cs2[2], cs3[0], cs3[2]};
      const float sv[8] = {cs0[1], cs0[3], cs1[1], cs1[3], cs2[1], cs2[3], cs3[1], cs3[3]};
      float x[8] = {a[0], a[1], a[2], a[3], b[0], b[1], b[2], b[3]}, o[8];
#pragma unroll
      for (int k = 0; k < 8; ++k) {
        const float px = __shfl_xor(x[k], 2);
        o[k] = (isx2 ? (px * sv[k] + x[k] * cv[k]) : (x[k] * cv[k] - px * sv[k])) * QS_C;
      }
      u32x4 ov = {pk2(o[0], o[1]), pk2(o[2], o[3]), pk2(o[4], o[5]), pk2(o[6], o[7])};
      *(u32x4*)(Qc + (size_t)grow * 1536 + ((nt - 8) * 4 + hq) * 96 + 64 + ci) = ov;
    }
  }
  };
  gemm_units(lds, QA, 512, Wt, 512, 512, NT / 256, 6, shift, epi);
}
DI void c_kv_gemm(const Ctx& c, unsigned char* lds, const bf16_t* A, bf16_t* Kn, bf16_t* Vt, int rows_per_b, int nrows, int shift) {
  const bf16_t* Wt = c.wsp<bf16_t>(WS_WCKVB);
  auto epi = [&](const float* Cs, int m0, int nt, int t) {
  const float* ckg = c.in[27];
  auto dst = [&](bf16_t* base, int hd0, int row, int c0) -> bf16_t* {
    const int grow = m0 + row, b = grow / rows_per_b, sk = grow - b * rows_per_b;
    return base + (((size_t)b * 16 + hd0 + (c0 >> 6)) * rows_per_b + sk) * 64 + (c0 & 63);
  };
  if (nt < 8) epi_rows<1, 64>(Cs, t, ckg, 1.f, [&](int row, int c0) { return dst(Kn, nt * 2, row, c0); }, NoF());
  else        epi_rows<0, 64>(Cs, t, nullptr, 1.f, [&](int row, int c0) { return dst(Vt, (nt - 8) * 2, row, c0); }, NoF());
  };
  gemm_units(lds, A, 256, Wt, 256, 256, nrows / 256, 8, shift, epi);
}
DI void phase_c_proj(const Ctx& c, unsigned char* lds, int round) {
  bf16_t* Knp = (bf16_t*)(c.out + O_SCR_KNP); bf16_t* Vtp = (bf16_t*)(c.out + O_SCR_VTP);
  if (round == 0) {
    c_q_gemm(c, lds, 0);
    c_kv_gemm(c, lds, c.wsp<bf16_t>(WS_CCKVP), Knp, Vtp, SEQ, NP, 0);
  }
  c_kv_gemm(c, lds, c.wsp<bf16_t>(WS_CCKVS) + (size_t)round * CROUND_B * CKEYS * 256, c.wsp<bf16_t>(WS_CKNS), c.wsp<bf16_t>(WS_CVTS), CKEYS, CROUND_B * CKEYS, 48);
}

DI void phase_gemm_out(const Ctx& c, unsigned char* lds, int layer, const bf16_t* Wt, bool dry) {
  const bf16_t* OG = c.wsp<bf16_t>(WS_SG);
  auto epi = [&](const float* Cs, int m0, int nt, int t) {
    const int n0 = nt * 128, rl = t >> 5, c4 = (t & 31) * 4;
#pragma unroll 4
    for (int p = 0; p < 16; ++p) {
      const int row = p * 8 + rl, grow = m0 + row;
      const f32x4 a = *(const f32x4*)(c.xin_row(layer, grow) + n0 + c4);
      const f32x4 v = *(const f32x4*)(Cs + row * C_STR + c4);
      if (!dry) *(f32x4*)(c.out + (size_t)grow * DM + n0 + c4) = a + v;
    }
  };
  gemm_units(lds, OG, LDX, Wt, LDX, DM, NT / 256, 4, 0, epi);
}

struct AttnItem {
  const bf16_t* k1; long ks1;
  const bf16_t* k2; long ks2;
  const bf16_t* vt; long vts;
  int t0, t1;
  const bf16_t* qrow;
  long qs;
  bf16_t* og;
  int cw;
  int qi0;
  float bslope;
  float m0, l0;
  bool dry;
};

template <int DQK, int DV, int BIAS, int BAND, int KCH1>
DI void attn_item(unsigned char* lds, const AttnItem& it) {
  constexpr int KSTR = DQK * 2 + 16, VSTR = DV * 2 + 64;
  constexpr int KBYTES = 64 * KSTR, VBYTES = 64 * VSTR;
  constexpr int KCH = DQK / 8, NKL = 64 * KCH / 256, VCH = DV / 8, NVL = 64 * VCH / 256;
  constexpr int NKS = DQK / 16, NDB = DV / 32;
  static_assert(2 * KBYTES + 2 * VBYTES + 1040 <= ATT_SUB_BYTES, "attn lds");
  int t = threadIdx.x & 255; asm volatile("" : "+v"(t));
  const int lane = t & 63, r = lane & 31, h = lane >> 5;
  unsigned char* Kl = lds; unsigned char* Vl = lds + 2 * KBYTES;
  const float* tab = (const float*)(lds + 2 * KBYTES + 2 * VBYTES);
  bf16x8 qf[NKS];
  {
    const bf16_t* qp = it.qrow + (long)r * it.qs + h * 8;
#pragma unroll
    for (int ks = 0; ks < NKS; ++ks) qf[ks] = *(const bf16x8*)(qp + ks * 16);
  }
  f32x16 o[NDB];
#pragma unroll
  for (int d = 0; d < NDB; ++d) o[d] = f32x16{};
  float m = it.m0, l = it.l0;
  u32x4 kr[NKL]; u32x4 vr[NVL];
  auto gload = [&](int tile) {
#pragma unroll
    for (int i = 0; i < NKL; ++i) {
      const int e = t + 256 * i, row = e / KCH, ch = e - row * KCH;
      const long key = (long)tile * 64 + row;
      const bf16_t* src = (ch < KCH1) ? it.k1 + key * it.ks1 + ch * 8 : it.k2 + key * it.ks2 + (ch - KCH1) * 8;
      kr[i] = *(const u32x4*)src;
    }
#pragma unroll
    for (int i = 0; i < NVL; ++i) {
      const int e = t + 256 * i, row = e / VCH, ch = e - row * VCH;
      vr[i] = *(const u32x4*)(it.vt + ((long)tile * 64 + row) * it.vts + ch * 8);
    }
  };
  auto lwrite = [&](int buf) {
#pragma unroll
    for (int i = 0; i < NKL; ++i) {
      const int e = t + 256 * i, row = e / KCH, ch = e - row * KCH;
      *(u32x4*)(Kl + buf * KBYTES + row * KSTR + ch * 16) = kr[i];
    }
#pragma unroll
    for (int i = 0; i < NVL; ++i) {
      const int e = t + 256 * i, row = e / VCH, ch = e - row * VCH;
      *(u32x4*)(Vl + buf * VBYTES + row * VSTR + ch * 16) = vr[i];
    }
  };
  gload(it.t0);
  __syncthreads();
  lwrite(0);
  __syncthreads();
  const int ntile = it.t1 - it.t0 + 1;
  for (int jt = 0; jt < ntile; ++jt) {
    const int buf = jt & 1, tile = it.t0 + jt;
    if (jt + 1 < ntile) gload(tile + 1);
    const bool active = (tile <= it.cw) && (tile >= it.cw - (BAND - 1));
    if (active) {
      f32x16 s0, s1;
      const int dt = it.cw - tile;
      const int dbase = dt * 64 + it.qi0 + r - 4 * h;
      if (BIAS == 1) {
        if (dt >= 3) { const float cb = tab[256];
#pragma unroll
          for (int i = 0; i < 16; ++i) { s0[i] = cb; s1[i] = cb; }
        } else {
#pragma unroll
          for (int i = 0; i < 16; ++i) {
            const int d0 = dbase - ((i & 3) + 8 * (i >> 2));
            s0[i] = tab[min(max(d0, -128), 128) + 128];
            s1[i] = tab[min(max(d0 - 32, -128), 128) + 128];
          }
        }
      } else if (BIAS == 2) {
#pragma unroll
        for (int i = 0; i < 16; ++i) {
          const int d0 = dbase - ((i & 3) + 8 * (i >> 2));
          s0[i] = -it.bslope * fabsf((float)d0);
          s1[i] = -it.bslope * fabsf((float)(d0 - 32));
        }
      } else {
#pragma unroll
        for (int i = 0; i < 16; ++i) { s0[i] = 0.f; s1[i] = 0.f; }
      }
      const unsigned char* kb = Kl + buf * KBYTES + r * KSTR + h * 16;
#pragma unroll
      for (int ks = 0; ks < NKS; ++ks) {
        bf16x8 k0 = *(const bf16x8*)(kb + ks * 32);
        bf16x8 k1 = *(const bf16x8*)(kb + 32 * KSTR + ks * 32);
        s0 = MFMA(k0, qf[ks], s0);
        s1 = MFMA(k1, qf[ks], s1);
      }
      float mx = s0[0];
#pragma unroll
      for (int i = 1; i < 16; ++i) mx = fmaxf(mx, s0[i]);
#pragma unroll
      for (int i = 0; i < 16; ++i) mx = fmaxf(mx, s1[i]);
      mx = fmaxf(mx, __shfl_xor(mx, 32));
      const float mn = fmaxf(m, mx);
      const float alpha = fast_exp2(m - mn);
      m = mn;
      float rs = 0.f;
#pragma unroll
      for (int i = 0; i < 16; ++i) { s0[i] = fast_exp2(s0[i] - mn); s1[i] = fast_exp2(s1[i] - mn); rs += s0[i] + s1[i]; }
      rs += __shfl_xor(rs, 32);
      l = l * alpha + rs;
#pragma unroll
      for (int d = 0; d < NDB; ++d)
#pragma unroll
        for (int i = 0; i < 16; ++i) o[d][i] *= alpha;
      bf16x8 pf[4];
      {
        u32x4 a = {pk2(s0[0], s0[1]), pk2(s0[2], s0[3]), pk2(s0[4], s0[5]), pk2(s0[6], s0[7])};
        u32x4 b = {pk2(s0[8], s0[9]), pk2(s0[10], s0[11]), pk2(s0[12], s0[13]), pk2(s0[14], s0[15])};
        u32x4 cc = {pk2(s1[0], s1[1]), pk2(s1[2], s1[3]), pk2(s1[4], s1[5]), pk2(s1[6], s1[7])};
        u32x4 dd = {pk2(s1[8], s1[9]), pk2(s1[10], s1[11]), pk2(s1[12], s1[13]), pk2(s1[14], s1[15])};
        pf[0] = __builtin_bit_cast(bf16x8, a); pf[1] = __builtin_bit_cast(bf16x8, b);
        pf[2] = __builtin_bit_cast(bf16x8, cc); pf[3] = __builtin_bit_cast(bf16x8, dd);
      }
      const LAS unsigned char* vb = (const LAS unsigned char*)(Vl + buf * VBYTES) + (4 * h + ((lane & 15) >> 2)) * VSTR + (16 * ((lane >> 4) & 1) + 4 * (lane & 3)) * 2;
#pragma unroll
      for (int d = 0; d < NDB; ++d) {
#pragma unroll
        for (int kk = 0; kk < 4; ++kk) {
          const LAS unsigned char* p = vb + kk * 16 * VSTR + d * 64;
          s16x4 lo = __builtin_amdgcn_ds_read_tr16_b64_v4i16((LAS s16x4*)p);
          s16x4 hi = __builtin_amdgcn_ds_read_tr16_b64_v4i16((LAS s16x4*)(p + 8 * VSTR));
          bf16x8 vf = {lo[0], lo[1], lo[2], lo[3], hi[0], hi[1], hi[2], hi[3]};
          o[d] = MFMA(vf, pf[kk], o[d]);
        }
      }
    }
    if (jt + 1 < ntile) lwrite(buf ^ 1);
    __syncthreads();
  }
  if (it.cw >= 0 && !it.dry) {
    const float linv = 1.f / l;
    constexpr int ROWB = DV * 2 + 16, CPR = DV / 8, RPP = 64 / CPR;
    unsigned char* Ol = lds + (t >> 6) * (32 * ROWB);
#pragma unroll
    for (int d = 0; d < NDB; ++d) {
#pragma unroll
      for (int g = 0; g < 4; ++g) {
        u32x2 v = {pk2(o[d][4 * g] * linv, o[d][4 * g + 1] * linv), pk2(o[d][4 * g + 2] * linv, o[d][4 * g + 3] * linv)};
        *(u32x2*)(Ol + r * ROWB + (d * 32 + 8 * g + 4 * h) * 2) = v;
      }
    }
    const int rrow = lane / CPR, ch = lane % CPR;
#pragma unroll
    for (int p = 0; p < 32 / RPP; ++p) {
      const int row = p * RPP + rrow;
      const u32x4 ov = *(const u32x4*)(Ol + row * ROWB + ch * 16);
      bf16_t* gp = it.og + (long)row * LDX + ch * 8;
      const u32x4 sg = *(const u32x4*)gp;
      u32x4 res;
#pragma unroll
      for (int k = 0; k < 4; ++k) res[k] = pk2(bf_lo(ov[k]) * bf_lo(sg[k]), bf_hi(ov[k]) * bf_hi(sg[k]));
      *(u32x4*)gp = res;
    }
  }
}

DI void phase_attn_a(const Ctx& c, unsigned char* lds0, int j, bool dry) {
  const int w = __builtin_amdgcn_readfirstlane(threadIdx.x >> 6) & 3, sub = __builtin_amdgcn_readfirstlane(threadIdx.x >> 8);
  unsigned char* lds = lds0 + sub * ATT_SUB_BYTES;
  const bf16_t* Q = c.wsp<bf16_t>(WS_AQ); const bf16_t* Kp = c.wsp<bf16_t>(WS_AKP); const bf16_t* Ks = c.wsp<bf16_t>(WS_AKS);
  const bf16_t* Vtp = c.wsp<bf16_t>(WS_AVTP); const bf16_t* Vts = c.wsp<bf16_t>(WS_AVTS); bf16_t* SG = c.wsp<bf16_t>(WS_SG);
  const float* rel = c.in[12] + (size_t)j * 8 * 257;
  float* tab = (float*)(lds + 2 * 64 * (128 * 2 + 16) + 2 * 64 * (128 * 2 + 64));
  const int nitems = 2048 + 256;
  for (int pair = blockIdx.x; pair * 2 < nitems; pair += gridDim.x) {
    const int item = pair * 2 + sub;
    AttnItem it;
    int hh;
    if (item < 2048) {
      const int p = item >> 6, bh = item & 63, b = bh >> 3; hh = bh & 7;
      const int c0 = 2 * p;
      it.k1 = Kp + (size_t)b * SEQ * DM + hh * 128; it.ks1 = DM;
      it.vt = Vtp + (size_t)b * SEQ * DM + hh * 128; it.vts = DM;
      it.t0 = c0 - 8 > 0 ? c0 - 8 : 0; it.t1 = c0 + 1;
      it.cw = c0 + (w >> 1); it.qi0 = (w & 1) * 32;
      const size_t tok = (size_t)b * SEQ + it.cw * 64 + it.qi0;
      it.qrow = Q + tok * DM + hh * 128; it.og = SG + tok * LDX + hh * 128;
    } else {
      const int u = item - 2048, b = u >> 3; hh = u & 7;
      it.k1 = Ks + (size_t)b * 576 * DM + hh * 128; it.ks1 = DM;
      it.vt = Vts + (size_t)b * 576 * DM + hh * 128; it.vts = DM;
      it.t0 = 0; it.t1 = 8;
      it.cw = w < 2 ? 8 : -1000; it.qi0 = (w & 1) * 32;
      const size_t tok = (size_t)NP + b * 64 + it.qi0;
      it.qrow = Q + tok * DM + hh * 128; it.og = SG + tok * LDX + hh * 128;
    }
    it.k2 = it.k1; it.ks2 = 0; it.qs = DM; it.bslope = 0.f; it.m0 = -1e30f; it.l0 = 0.f; it.dry = dry;
    __syncthreads();
    for (int i = threadIdx.x & 255; i < 257; i += 256) tab[i] = rel[hh * 257 + i] * LOG2E;
    attn_item<128, 128, 1, 9, 16>(lds, it);
  }
}
DI void phase_attn_b(const Ctx& c, unsigned char* lds0, bool dry) {
  const int w = __builtin_amdgcn_readfirstlane(threadIdx.x >> 6) & 3, sub = __builtin_amdgcn_readfirstlane(threadIdx.x >> 8);
  unsigned char* lds = lds0 + sub * ATT_SUB_BYTES;
  const bf16_t* Q = c.wsp<bf16_t>(WS_BQ); const bf16_t* Kp = c.wsp<bf16_t>(WS_BKP); const bf16_t* Ks = c.wsp<bf16_t>(WS_BKS);
  const bf16_t* Vtp = c.wsp<bf16_t>(WS_BVTP); const bf16_t* Vts = c.wsp<bf16_t>(WS_BVTS); bf16_t* SG = c.wsp<bf16_t>(WS_SG);
  const float* sinks = c.in[18];
  const int nitems = 4096 + 256;
  for (int pair = blockIdx.x; pair * 2 < nitems; pair += gridDim.x) {
    const int item = pair * 2 + sub;
    AttnItem it;
    int head;
    if (item < 4096) {
      const int gp = item & 1, hk = (item >> 1) & 3, cc = (item >> 3) & 63, b = item >> 9;
      head = hk * 4 + gp * 2 + (w >> 1);
      it.k1 = Kp + (size_t)b * SEQ * 256 + hk * 64; it.ks1 = 256;
      it.vt = Vtp + (size_t)b * SEQ * 256 + hk * 64; it.vts = 256;
      it.t0 = cc - 2 > 0 ? cc - 2 : 0; it.t1 = cc;
      it.cw = cc; it.qi0 = (w & 1) * 32;
      const size_t tok = (size_t)b * SEQ + cc * 64 + it.qi0;
      it.qrow = Q + tok * DM + head * 64; it.og = SG + tok * LDX + head * 64;
    } else {
      const int u = item - 4096, gp = u & 1, hk = (u >> 1) & 3, b = u >> 3;
      head = hk * 4 + gp * 2 + (w >> 1);
      it.k1 = Ks + (size_t)b * 192 * 256 + hk * 64; it.ks1 = 256;
      it.vt = Vts + (size_t)b * 192 * 256 + hk * 64; it.vts = 256;
      it.t0 = 0; it.t1 = 2;
      it.cw = 2; it.qi0 = (w & 1) * 32;
      const size_t tok = (size_t)NP + b * 64 + it.qi0;
      it.qrow = Q + tok * DM + head * 64; it.og = SG + tok * LDX + head * 64;
    }
    it.k2 = it.k1; it.ks2 = 0; it.qs = DM;
    it.bslope = exp2f(-0.5f * (float)(head + 1)) * LOG2E;
    it.m0 = sinks[head] * LOG2E; it.l0 = 1.f; it.dry = dry;
    attn_item<64, 64, 2, 3, 8>(lds, it);
  }
}
DI void phase_attn_c(const Ctx& c, unsigned char* lds0, int round, bool dry) {
  const int w = __builtin_amdgcn_readfirstlane(threadIdx.x >> 6) & 3, sub = __builtin_amdgcn_readfirstlane(threadIdx.x >> 8);
  unsigned char* lds = lds0 + sub * ATT_SUB_BYTES;
  const bf16_t* Qc = c.wsp<bf16_t>(WS_CQ); bf16_t* SG = c.wsp<bf16_t>(WS_SG);
  const bf16_t* Knp = (const bf16_t*)(c.out + O_SCR_KNP); const bf16_t* Vtp = (const bf16_t*)(c.out + O_SCR_VTP);
  const bf16_t* KRp = c.wsp<bf16_t>(WS_CKRP); const bf16_t* KRs = c.wsp<bf16_t>(WS_CKRS);
  const bf16_t* Kns = c.wsp<bf16_t>(WS_CKNS); const bf16_t* Vts = c.wsp<bf16_t>(WS_CVTS);
  const int npr = round == 0 ? 4096 : 0;
  const int nitems = npr + CROUND_B * 16;
  for (int pair = blockIdx.x; pair * 2 < nitems; pair += gridDim.x) {
    const int item = pair * 2 + sub;
    AttnItem it;
    if (item < npr) {
      const int p = 31 - (item >> 7), bh = item & 127, b = bh >> 4, hh = bh & 15;
      it.k1 = Knp + ((size_t)b * 16 + hh) * SEQ * 64; it.ks1 = 64;
      it.k2 = KRp + (size_t)b * SEQ * 32; it.ks2 = 32;
      it.vt = Vtp + ((size_t)b * 16 + hh) * SEQ * 64; it.vts = 64;
      it.t0 = 0; it.t1 = 2 * p + 1;
      it.cw = 2 * p + (w >> 1); it.qi0 = (w & 1) * 32;
      const size_t tok = (size_t)b * SEQ + it.cw * 64 + it.qi0;
      it.qrow = Qc + tok * 1536 + hh * 96; it.og = SG + tok * LDX + hh * 64;
    } else {
      const int u = item - npr, bl = u >> 4, hh = u & 15, b = round * CROUND_B + bl;
      it.k1 = Kns + ((size_t)bl * 16 + hh) * CKEYS * 64; it.ks1 = 64;
      it.k2 = KRs + (size_t)b * CKEYS * 32; it.ks2 = 32;
      it.vt = Vts + ((size_t)bl * 16 + hh) * CKEYS * 64; it.vts = 64;
      it.t0 = 0; it.t1 = 32;
      it.cw = w < 2 ? 32 : -1000; it.qi0 = (w & 1) * 32;
      const size_t tok = (size_t)NP + b * 64 + it.qi0;
      it.qrow = Qc + tok * 1536 + hh * 96; it.og = SG + tok * LDX + hh * 64;
    }
    it.qs = 1536; it.bslope = 0.f; it.m0 = -1e30f; it.l0 = 0.f; it.dry = dry;
    attn_item<96, 64, 0, 100000, 8>(lds, it);
  }
}

constexpr int N_PHASES = 20;
__global__ void __launch_bounds__(NTHR, 2) mega(Params P) {
  __shared__ __attribute__((aligned(16))) unsigned char lds[LDS_BYTES + 16];
  Ctx c{P.in, P.out, P.ws};
  const int lo = P.ph_lo, hi = P.ph_hi;
#if MODE_COOP
  if (threadIdx.x < 4) ((volatile LAS unsigned*)(lds + LDS_BYTES))[threadIdx.x] = 0u;
  __syncthreads();
  XcdBarrier xbar = xcd_barrier_post((unsigned*)(P.ws + WS_CTL), (volatile LAS unsigned*)(lds + LDS_BYTES));
  if (P.ph_lo < 0) cg::this_grid().sync();
#endif
#define IN(k) (lo <= (k) && (k) < hi)
#if MODE_COOP
#define SEAM(k) do { if (IN(k) && IN((k) + 1)) xcd_barrier(xbar); } while (0)
#else
#define SEAM(k) do { } while (0)
#endif
  const bool dryf = P.ph_lo >= 0;
#define RUN(k, ...) do { if (IN(k)) { if ((PROBE_DUP >> (k)) & 1u) { const bool dry = dryf; __VA_ARGS__; } { const bool dry = false; __VA_ARGS__; } } SEAM(k); } while (0)
  RUN(0, (void)dry; phase_prep(c); phase_xn(c, 0, c.in[8]);
         conv_cache(c.in[2], c.in[3], c.wsp<bf16_t>(WS_AKS), c.wsp<bf16_t>(WS_AVTS), c.out + O_AKS, c.out + O_AVS, 512, 8, 128));
  RUN(1, (void)dry; phase_gemm_a_in(c, lds, 0));
  RUN(2, phase_attn_a(c, lds, 0, dry));
  RUN(3, phase_gemm_out(c, lds, 0, c.wsp<bf16_t>(WS_WAOUT), dry));
  RUN(4, (void)dry; phase_xn(c, 1, c.in[14]);
         conv_cache(c.in[4], c.in[5], c.wsp<bf16_t>(WS_BKS), c.wsp<bf16_t>(WS_BVTS), c.out + O_BKS, c.out + O_BVS, 128, 4, 64));
  RUN(5, (void)dry; phase_gemm_b_in(c, lds));
  RUN(6, phase_attn_b(c, lds, dry));
  RUN(7, phase_gemm_out(c, lds, 1, c.wsp<bf16_t>(WS_WBOUT), dry));
  RUN(8, (void)dry; phase_xn(c, 2, c.in[20]));
  RUN(9, (void)dry; phase_gemm_c_in(c, lds));
  RUN(10, (void)dry; phase_c_norm(c); conv_cache_c(c));
  RUN(11, (void)dry; phase_c_proj(c, lds, 0));
  RUN(12, phase_attn_c(c, lds, 0, dry));
  RUN(13, (void)dry; phase_c_proj(c, lds, 1));
  RUN(14, phase_attn_c(c, lds, 1, dry));
  RUN(15, phase_gemm_out(c, lds, 2, c.wsp<bf16_t>(WS_WCOUT), dry));
  RUN(16, (void)dry; phase_xn(c, 3, c.in[8] + 1024);
          conv_cache(c.in[2] + (size_t)SBATCH * 512 * 1024, c.in[3] + (size_t)SBATCH * 512 * 1024, c.wsp<bf16_t>(WS_AKS), c.wsp<bf16_t>(WS_AVTS),
                     c.out + O_AKS + 16777216, c.out + O_AVS + 16777216, 512, 8, 128));
  RUN(17, (void)dry; phase_gemm_a_in(c, lds, 1));
  RUN(18, phase_attn_a(c, lds, 1, dry));
  RUN(19, phase_gemm_out(c, lds, 3, c.wsp<bf16_t>(WS_WAOUT) + (size_t)1024 * LDX, dry));
#undef RUN
#undef IN
#undef SEAM
}

extern "C" void kernel_launch(void* const* d_in, const int* in_sizes, int n_in, void* d_out, int out_size, void* d_ws, size_t ws_size, hipStream_t stream) {
  static int grid = 0;
  if (grid == 0) {
    if (n_in != 29 || (size_t)out_size != O_END || ws_size < WS_NEED) {
      fprintf(stderr, "kernel_launch: unexpected shapes: n_in %d out %d ws %zu (need %zu)\n", n_in, out_size, ws_size, (size_t)WS_NEED);
      grid = -1; return;
    }
    int dev = 0, cus = 0, per_cu = 0;
    hipGetDevice(&dev);
    hipDeviceGetAttribute(&cus, hipDeviceAttributeMultiprocessorCount, dev);
    hipOccupancyMaxActiveBlocksPerMultiprocessor(&per_cu, (const void*)mega, NTHR, 0);
    if (per_cu < 1) { fprintf(stderr, "kernel_launch: occupancy query returned %d\n", per_cu); grid = -1; return; }
    per_cu = 1;
    grid = cus * per_cu;
    fprintf(stderr, "kernel_launch: grid %d (%d CUs x %d)\n", grid, cus, per_cu);
  }
  if (grid < 0) return;
  Params p{};
  for (int i = 0; i < 29; ++i) p.in[i] = (const float*)d_in[i];
  p.out = (float*)d_out; p.ws = (unsigned char*)d_ws;
#if MODE_COOP
  if (hipMemsetAsync((char*)d_ws + WS_CTL, 0, WS_CTL_BYTES, stream) != hipSuccess) { fprintf(stderr, "kernel_launch: memset failed\n"); return; }
  p.ph_lo = 0; p.ph_hi = N_PHASES;
  void* args[] = {&p};
  hipError_t e = hipLaunchCooperativeKernel((const void*)mega, dim3(grid), dim3(NTHR), args, 0, stream);
  if (e != hipSuccess) fprintf(stderr, "cooperative launch failed: %s (grid %d)\n", hipGetErrorString(e), grid);
#else
  for (int ph = 0; ph < 20; ++ph) {
    p.ph_lo = ph; p.ph_hi = ph + 1;
    hipLaunchKernelGGL(mega, dim3(grid), dim3(NTHR), 0, stream, p);
  }
#endif
}
```

```cpp
#include <hip/hip_runtime.h>
#include <hip/hip_cooperative_groups.h>
#include <cstdio>
#include <cstdint>
namespace cg = cooperative_groups;

#ifndef MODE_COOP
#define MODE_COOP 1
#endif
#ifndef PROBE_MODE
#define PROBE_MODE 0
#endif
#ifndef PROBE_DUP
#define PROBE_DUP 0u
#endif

#define DI __device__ __forceinline__
typedef unsigned short bf16_t;
using bf16x8 = __attribute__((ext_vector_type(8))) short;
using s16x4  = __attribute__((ext_vector_type(4))) short;
using f32x16 = __attribute__((ext_vector_type(16))) float;
using f32x4  = __attribute__((ext_vector_type(4))) float;
using u32x4  = __attribute__((ext_vector_type(4))) unsigned;
using u32x2  = __attribute__((ext_vector_type(2))) unsigned;
typedef __bf16 bf2_t __attribute__((ext_vector_type(2)));
typedef float f2_t __attribute__((ext_vector_type(2)));
#define MFMA(a, b, c) __builtin_amdgcn_mfma_f32_32x32x16_bf16((a), (b), (c), 0, 0, 0)

DI unsigned pk2(float lo, float hi) { f2_t v = {lo, hi}; return __builtin_bit_cast(unsigned, __builtin_convertvector(v, bf2_t)); }
DI float bf_lo(unsigned u) { return __uint_as_float(u << 16); }
DI float bf_hi(unsigned u) { return __uint_as_float(u & 0xffff0000u); }
DI int crow(int i, int h) { return (i & 3) + 8 * (i >> 2) + 4 * h; }
DI float wave_sum(float v) {
#pragma unroll
  for (int o = 32; o >= 1; o >>= 1) v += __shfl_xor(v, o);
  return v;
}
DI float fast_exp2(float x) { return __builtin_amdgcn_exp2f(x); }
DI float half_max(float v) { auto rr = __builtin_amdgcn_permlane32_swap(__float_as_uint(v), __float_as_uint(v), false, false); return fmaxf(__uint_as_float(rr[0]), __uint_as_float(rr[1])); }
DI float half_sum(float v) { auto rr = __builtin_amdgcn_permlane32_swap(__float_as_uint(v), __float_as_uint(v), false, false); return __uint_as_float(rr[0]) + __uint_as_float(rr[1]); }
DI float silu(float g) { return g / (1.f + __expf(-g)); }

#define XB_TMO      128
#define XB_XCNT(j)  (256  + 64 * (j))
#define XB_XSUB(j)  (1280 + 64 * (j))
#define XB_XGEN(j)  (2304 + 64 * (j))
#define XB_TOP      3328
#define XB_TOPGEN   3392
#define XCD_BAR_WORDS 3456
#define XB_SPIN_CAP (1u << 22)
#define LAS __attribute__((address_space(3)))
DI unsigned xb_ld(unsigned* p)              { return __hip_atomic_load(p, __ATOMIC_RELAXED, __HIP_MEMORY_SCOPE_AGENT); }
DI unsigned xb_add(unsigned* p, unsigned v) { return __hip_atomic_fetch_add(p, v, __ATOMIC_RELAXED, __HIP_MEMORY_SCOPE_AGENT); }
DI unsigned xb_xcc_id() { return (unsigned)__builtin_amdgcn_s_getreg((3 << 11) | 20) & 0xFu; }
#define XB_SPIN(cond, bar) do { unsigned _sp = 0; while (cond) { __builtin_amdgcn_s_sleep(1); \
    if ((++_sp & 255u) == 0u) { if (xb_ld(&(bar)[XB_TMO])) break; if (_sp > XB_SPIN_CAP) { atomicAdd(&(bar)[XB_TMO], 1u); break; } } } } while (0)
struct XcdBarrier { unsigned* bar; unsigned x; volatile LAS unsigned* st; };
DI XcdBarrier xcd_barrier_post(unsigned* bar, volatile LAS unsigned* st) {
  XcdBarrier b; b.bar = bar; b.x = xb_xcc_id(); b.st = st;
  if (threadIdx.x == 0) (void)xb_add(&bar[XB_XCNT(b.x)], 1u);
  return b;
}
DI void xcd_barrier_complete(unsigned* bar, unsigned x, unsigned& nloc, unsigned& nx) {
  const unsigned G = gridDim.x * gridDim.y * gridDim.z;
  unsigned sum, cnt, mine, sp = 0u;
  for (;;) {
    sum = 0u; cnt = 0u; mine = 0u;
#pragma unroll
    for (unsigned j = 0; j < 16; ++j) { const unsigned c = xb_ld(&bar[XB_XCNT(j)]); sum += c; cnt += (c > 0u) ? 1u : 0u; mine = (j == x) ? c : mine; }
    if (sum == G) break;
    __builtin_amdgcn_s_sleep(1);
    if ((++sp & 255u) == 0u) { if (xb_ld(&bar[XB_TMO])) break; if (sp > XB_SPIN_CAP) { atomicAdd(&bar[XB_TMO], 1u); break; } }
  }
  nloc = mine > 0u ? mine : 1u; nx = cnt > 0u ? cnt : 1u;
}
DI void xcd_barrier(const XcdBarrier& b) {
  asm volatile("s_waitcnt vmcnt(0)" ::: "memory");
  __syncthreads();
  if (threadIdx.x == 0) {
    unsigned* bar = b.bar;
    __builtin_amdgcn_s_waitcnt(0);
    unsigned nloc = b.st[0], nx = b.st[1];
    if (nloc == 0u) { xcd_barrier_complete(bar, b.x, nloc, nx); b.st[0] = nloc; b.st[1] = nx; }
    const unsigned old = xb_add(&bar[XB_XSUB(b.x)], 1u);
    const unsigned gen = old / nloc;
    if (old + 1u == (gen + 1u) * nloc) {
      __builtin_amdgcn_fence(__ATOMIC_RELEASE, "agent");
      asm volatile("s_waitcnt vmcnt(0)" ::: "memory");
      const unsigned og = xb_add(&bar[XB_TOP], 1u);
      const unsigned tg = og / nx;
      if (og + 1u == (tg + 1u) * nx) xb_add(&bar[XB_TOPGEN], 1u);
      else XB_SPIN(xb_ld(&bar[XB_TOPGEN]) == tg, bar);
      __builtin_amdgcn_fence(__ATOMIC_ACQUIRE, "agent");
      xb_add(&bar[XB_XGEN(b.x)], 1u);
      asm volatile("s_waitcnt vmcnt(0)" ::: "memory");
    } else {
      XB_SPIN(xb_ld(&bar[XB_XGEN(b.x)]) == gen, bar);
      __builtin_amdgcn_fence(__ATOMIC_ACQUIRE, "agent");
      asm volatile("s_waitcnt vmcnt(0)" ::: "memory");
    }
  }
  __syncthreads();
}

constexpr int DM = 1024;
constexpr int LDX = 1088;
constexpr int SEQ = 4096, PB = 8, SBATCH = 32, DSEQ = 64, PAST = 2048;
constexpr int NP = PB * SEQ;
constexpr int NS = SBATCH * DSEQ;
constexpr int NT = NP + NS;
constexpr float EPS = 1e-6f;
constexpr float LOG2E = 1.4426950408889634f;
constexpr float QS_A = 0.08838834764831845f * LOG2E;
constexpr float QS_B = 0.125f * LOG2E;
constexpr float QS_C = 0.10206207261596575f * LOG2E;
constexpr int CKEYS = PAST + DSEQ;
constexpr int CROUND_B = 16;

constexpr size_t O_Y      = 0;
constexpr size_t O_AKP    = O_Y + (size_t)NT * DM;
constexpr size_t O_AVP    = O_AKP + 8388608;
constexpr size_t O_BKP    = O_AVP + 8388608;
constexpr size_t O_BVP    = O_BKP + 262144;
constexpr size_t O_CKVP   = O_BVP + 262144;
constexpr size_t O_CKRP   = O_CKVP + 8388608;
constexpr size_t O_AKS    = O_CKRP + 1048576;
constexpr size_t O_AVS    = O_AKS + 33554432;
constexpr size_t O_BKS    = O_AVS + 33554432;
constexpr size_t O_BVS    = O_BKS + 1048576;
constexpr size_t O_CKVS   = O_BVS + 1048576;
constexpr size_t O_CKRS   = O_CKVS + 524288;
constexpr size_t O_END    = O_CKRS + 65536;
static_assert(O_END == 132186112, "output size");

constexpr size_t WS_CTL   = 0;
constexpr size_t WS_SS    = 16384;
constexpr size_t WS_CTL_BYTES = 16384 + 3 * (size_t)NT * 4;
constexpr size_t WS_WAIN  = WS_CTL + WS_CTL_BYTES;
constexpr size_t WS_WAOUT = WS_WAIN + 2 * (size_t)4096 * LDX * 2;
constexpr size_t WS_WBIN  = WS_WAOUT + 2 * (size_t)1024 * LDX * 2;
constexpr size_t WS_WBOUT = WS_WBIN + (size_t)2560 * LDX * 2;
constexpr size_t WS_WCIN  = WS_WBOUT + (size_t)1024 * LDX * 2;
constexpr size_t WS_WCQB  = WS_WCIN + (size_t)2048 * LDX * 2;
constexpr size_t WS_WCKVB = WS_WCQB + 1572864;
constexpr size_t WS_WCOUT = WS_WCKVB + 1048576;
constexpr size_t WS_ROPE  = WS_WCOUT + (size_t)1024 * LDX * 2;
constexpr size_t WS_SG    = WS_ROPE + 524288;
constexpr size_t WS_X     = WS_SG + (size_t)NT * LDX * 2;
constexpr size_t WS_L     = WS_X + (size_t)NT * LDX * 2;
constexpr size_t WS_AQ    = WS_L;
constexpr size_t WS_AKP   = WS_AQ + (size_t)NT * DM * 2;
constexpr size_t WS_AKS   = WS_AKP + (size_t)NP * DM * 2;
constexpr size_t WS_AVTP  = WS_AKS + (size_t)32 * 576 * 1024 * 2;
constexpr size_t WS_AVTS  = WS_AVTP + (size_t)NP * DM * 2;
constexpr size_t WS_AEND  = WS_AVTS + (size_t)32 * 576 * 1024 * 2;
constexpr size_t WS_BQ    = WS_L;
constexpr size_t WS_BKP   = WS_BQ + (size_t)NT * DM * 2;
constexpr size_t WS_BKS   = WS_BKP + (size_t)NP * 256 * 2;
constexpr size_t WS_BVTP  = WS_BKS + (size_t)32 * 192 * 256 * 2;
constexpr size_t WS_BVTS  = WS_BVTP + (size_t)NP * 256 * 2;
constexpr size_t WS_BEND  = WS_BVTS + (size_t)32 * 192 * 256 * 2;
constexpr size_t WS_CZ    = WS_L;
constexpr size_t WS_CQ    = WS_L;
constexpr size_t WS_CCKVP = WS_CZ + (size_t)NT * 800 * 4;
constexpr size_t WS_CKRP  = WS_CCKVP + (size_t)NP * 256 * 2;
constexpr size_t WS_CKRS  = WS_CKRP + (size_t)NP * 32 * 2;
constexpr size_t WS_CKNS  = WS_CKRS + (size_t)32 * CKEYS * 32 * 2;
constexpr size_t WS_CVTS  = WS_CKNS + (size_t)CROUND_B * 16 * CKEYS * 64 * 2;
constexpr size_t WS_CEND  = WS_CVTS + (size_t)CROUND_B * 16 * CKEYS * 64 * 2;
constexpr size_t WS_CQA   = WS_X;
constexpr size_t WS_CCKVS = WS_CQA + (size_t)NT * 512 * 2;
static_assert(WS_CCKVS + (size_t)32 * CKEYS * 256 * 2 <= WS_L, "QA + CKVs must fit in X region");
static_assert((size_t)NT * 1536 * 2 <= (size_t)NT * 800 * 4, "Qc fits in Z region");
constexpr size_t WS_NEED  = WS_AEND > WS_CEND ? (WS_AEND > WS_BEND ? WS_AEND : WS_BEND) : (WS_CEND > WS_BEND ? WS_CEND : WS_BEND);
constexpr size_t O_SCR_KNP = O_AKS + 16777216;
constexpr size_t O_SCR_VTP = O_AVS + 16777216;

struct Params {
  const float* in[29];
  float* out;
  unsigned char* ws;
  int ph_lo, ph_hi;
};

constexpr int NTHR = 512;
constexpr int ATT_SUB_BYTES = 76816;
constexpr int LDS_BYTES = 2 * ATT_SUB_BYTES;
constexpr int C_STR = 132;
static_assert(8 * 16384 <= LDS_BYTES && 2 * 128 * C_STR * 4 <= LDS_BYTES, "lds");

constexpr int HTB = 16384;
DI int lds_byte(int r, int c) { const int st = (r >> 4) * 2 + (c >> 5), rr = r & 15, cc = c & 31, ob = rr * 64 + cc * 2; return st * 1024 + (ob ^ (((ob >> 9) & 1) << 5)); }
DI void stage_rc(int b, int& R, int& C) { const int st = b / 1024, sb = b % 1024, swz = sb ^ (((sb >> 9) & 1) << 5); R = (st >> 1) * 16 + swz / 64; C = (st & 1) * 32 + (swz % 64) / 2; }
DI bool unit_order(long L, int nM, int nN, int& pm, int& pn) {
  const int nwg = nM * nN; if (L >= nwg) return false;
  int wgid = (int)L; { const int q = nwg / 8, r = nwg % 8, xcd = wgid % 8, off = wgid / 8; wgid = (xcd < r ? xcd * (q + 1) : r * (q + 1) + (xcd - r) * q) + off; }
  const int nig = 8 * nN, gid = wgid / nig, fm = gid * 8, gsz = (nM - fm) < 8 ? (nM - fm) : 8;
  pm = fm + ((wgid % nig) % gsz); pn = (wgid % nig) / gsz; return true;
}
DI void gemm256_mainloop(unsigned char* ldsg, const bf16_t* A, long lda, const bf16_t* Bt, long ldb, int K, f32x4 (&acc)[2][2][4][2]) {
  LAS unsigned char* lds = (LAS unsigned char*)ldsg;
  int tid = threadIdx.x; asm volatile("" : "+v"(tid));
  const int wid = __builtin_amdgcn_readfirstlane(tid >> 6), lane = tid & 63, wr = wid >> 2, wc = wid & 3, fr = lane & 15, fq = lane >> 4;
  const int nt = K >> 6;
  unsigned voffA[2], voffB[2];
#pragma unroll
  for (int i = 0; i < 2; ++i) { int R, C; stage_rc(tid * 16 + i * 8192, R, C); voffA[i] = (unsigned)(R * lda + C) * 2u; voffB[i] = (unsigned)(R * ldb + C) * 2u; }
  const size_t kstep = 128, hstepA = (size_t)128 * lda * 2, hstepB = (size_t)128 * ldb * 2;
  const unsigned ldsw = (unsigned)wid * 1024u;
  const int aoff = lds_byte(wr * 64 + fr, fq * 8), boff = lds_byte(wc * 32 + fr, fq * 8);
  const char* cA = (const char*)A; const char* cB = (const char*)Bt;
#define G_SA(b, h) (((b) * 2 + (h)) * HTB)
#define G_SB(b, h) ((4 + (b) * 2 + (h)) * HTB)
#define G_STAGE(bufoff, gbase, voff) do { _Pragma("unroll") for (int _i = 0; _i < 2; ++_i) \
    __builtin_amdgcn_global_load_lds((const unsigned*)((const char*)(gbase) + (voff)[_i]), (LAS unsigned*)(lds + (bufoff) + ldsw + _i * 8192), 16, 0, 0); } while (0)
#define G_LDA(dst, b, h) do { _Pragma("unroll") for (int m = 0; m < 4; ++m) _Pragma("unroll") for (int k = 0; k < 2; ++k) dst[m][k] = *(const LAS bf16x8*)(lds + G_SA(b, h) + aoff + m * 2048 + k * 1024); } while (0)
#define G_LDB(dst, b, h) do { _Pragma("unroll") for (int n = 0; n < 2; ++n) _Pragma("unroll") for (int k = 0; k < 2; ++k) dst[n][k] = *(const LAS bf16x8*)(lds + G_SB(b, h) + boff + n * 2048 + k * 1024); } while (0)
#define G_MMA(ai, bj, At, Bt_) do { __builtin_amdgcn_s_setprio(1); _Pragma("unroll") for (int m = 0; m < 4; ++m) _Pragma("unroll") for (int n = 0; n < 2; ++n) _Pragma("unroll") for (int k = 0; k < 2; ++k) \
    acc[ai][bj][m][n] = __builtin_amdgcn_mfma_f32_16x16x32_bf16(Bt_[n][k], At[m][k], acc[ai][bj][m][n], 0, 0, 0); __builtin_amdgcn_s_setprio(0); } while (0)
#define G_WAIT_V(n) asm volatile("s_waitcnt vmcnt(" #n ")" ::: "memory")
#define G_WAIT_L(n) asm volatile("s_waitcnt lgkmcnt(" #n ")" ::: "memory")
#define G_BAR __builtin_amdgcn_s_barrier()
#define G_SCHED __builtin_amdgcn_sched_barrier(0)
#pragma unroll
  for (int a = 0; a < 2; ++a)
#pragma unroll
    for (int b = 0; b < 2; ++b)
#pragma unroll
      for (int m = 0; m < 4; ++m)
#pragma unroll
        for (int n = 0; n < 2; ++n) acc[a][b][m][n] = (f32x4){0.f, 0.f, 0.f, 0.f};
  bf16x8 At[4][2], B0[2][2], B1[2][2];
  G_STAGE(G_SB(0, 0), cB, voffB); G_STAGE(G_SA(0, 0), cA, voffA); G_STAGE(G_SB(0, 1), cB + hstepB, voffB); G_STAGE(G_SA(0, 1), cA + hstepA, voffA);
  if (wr == 1) G_BAR;
  G_WAIT_V(4); G_BAR;
  G_STAGE(G_SB(1, 0), cB + kstep, voffB); G_STAGE(G_SA(1, 0), cA + kstep, voffA); G_STAGE(G_SB(1, 1), cB + hstepB + kstep, voffB);
  G_WAIT_V(6); G_BAR;
  for (int t = 0; t < nt - 2; t += 2) {
    const char* a1 = cA + (size_t)(t + 1) * kstep;
    const char* a2 = cA + (size_t)(t + 2) * kstep; const char* b2 = cB + (size_t)(t + 2) * kstep;
    const char* a3 = a2 + kstep; const char* b3 = b2 + kstep;
    G_LDB(B0, 0, 0); G_SCHED; G_LDA(At, 0, 0); G_STAGE(G_SA(1, 1), a1 + hstepA, voffA);
    G_WAIT_L(8); G_BAR; G_WAIT_L(0); G_MMA(0, 0, At, B0); G_BAR; G_SCHED;
    G_LDB(B1, 0, 1); G_STAGE(G_SB(0, 0), b2, voffB);
    G_BAR; G_WAIT_L(0); G_MMA(0, 1, At, B1); G_BAR;
    G_LDA(At, 0, 1); G_STAGE(G_SA(0, 0), a2, voffA);
    G_BAR; G_WAIT_L(0); G_MMA(1, 0, At, B0); G_BAR; G_SCHED;
    G_STAGE(G_SB(0, 1), b2 + hstepB, voffB);
    G_WAIT_V(6); G_BAR; G_MMA(1, 1, At, B1); G_BAR;
    G_LDB(B0, 1, 0); G_SCHED; G_LDA(At, 1, 0); G_STAGE(G_SA(0, 1), a2 + hstepA, voffA);
    G_WAIT_L(8); G_BAR; G_WAIT_L(0); G_MMA(0, 0, At, B0); G_BAR; G_SCHED;
    G_LDB(B1, 1, 1); G_STAGE(G_SB(1, 0), b3, voffB);
    G_BAR; G_WAIT_L(0); G_MMA(0, 1, At, B1); G_BAR;
    G_LDA(At, 1, 1); G_STAGE(G_SA(1, 0), a3, voffA);
    G_BAR; G_WAIT_L(0); G_MMA(1, 0, At, B0); G_BAR; G_SCHED;
    G_STAGE(G_SB(1, 1), b3 + hstepB, voffB);
    G_WAIT_V(6); G_BAR; G_MMA(1, 1, At, B1); G_BAR;
  }
  { G_LDB(B0, 0, 0); G_LDA(At, 0, 0); G_STAGE(G_SA(1, 1), cA + (size_t)(nt - 1) * kstep + hstepA, voffA);
    G_BAR; G_WAIT_L(0); G_MMA(0, 0, At, B0); G_BAR;
    G_LDB(B1, 0, 1); G_BAR; G_WAIT_L(0); G_MMA(0, 1, At, B1); G_BAR;
    G_LDA(At, 0, 1); G_WAIT_V(4); G_BAR; G_WAIT_L(0); G_MMA(1, 0, At, B0); G_MMA(1, 1, At, B1); G_BAR; }
  { G_LDB(B0, 1, 0); G_LDA(At, 1, 0); G_WAIT_V(2); G_BAR; G_WAIT_L(0); G_MMA(0, 0, At, B0); G_BAR;
    G_LDB(B1, 1, 1); G_WAIT_V(0); G_BAR; G_WAIT_L(0); G_MMA(0, 1, At, B1); G_BAR;
    G_LDA(At, 1, 1); G_BAR; G_WAIT_L(0); G_MMA(1, 0, At, B0); G_MMA(1, 1, At, B1); G_BAR; }
  if (wr == 0) G_BAR;
#undef G_SA
#undef G_SB
#undef G_STAGE
#undef G_LDA
#undef G_LDB
#undef G_MMA
#undef G_WAIT_V
#undef G_WAIT_L
#undef G_BAR
#undef G_SCHED
}
constexpr int CS_FLOATS = 128 * C_STR;
template <class Pre, class Epi>
DI void gemm256_unit(unsigned char* lds, const bf16_t* A, long lda, const bf16_t* Bt, long ldb, int K, int m0, int nt0, const Pre& pre, const Epi& epi) {
  f32x4 acc[2][2][4][2];
  gemm256_mainloop(lds, A, lda, Bt, ldb, K, acc);
  int tid = threadIdx.x; asm volatile("" : "+v"(tid));
  const int wid = tid >> 6, lane = tid & 63, wr = wid >> 2, wc = wid & 3, fr = lane & 15, fq = lane >> 4;
  float* Cs = (float*)lds;
  const int sub = tid >> 8;
#pragma unroll
  for (int ai = 0; ai < 2; ++ai) {
    const auto pf = pre(m0 + ai * 128, nt0 + sub, tid & 255);
#pragma unroll
    for (int bj = 0; bj < 2; ++bj)
#pragma unroll
      for (int m = 0; m < 4; ++m)
#pragma unroll
        for (int n = 0; n < 2; ++n)
          *(f32x4*)(Cs + bj * CS_FLOATS + (wr * 64 + m * 16 + fr) * C_STR + wc * 32 + n * 16 + 4 * fq) = acc[ai][bj][m][n];
    __syncthreads();
    epi((const float*)(Cs + sub * CS_FLOATS), m0 + ai * 128, nt0 + sub, tid & 255, pf);
    __syncthreads();
  }
}
template <class Pre, class Epi>
DI void gemm_units(unsigned char* lds, const bf16_t* A, long lda, const bf16_t* Bt, long ldb, int K, int nM, int nN, int shift, const Pre& pre, const Epi& epi) {
  const int G = gridDim.x; int c = (int)blockIdx.x - shift; if (c < 0) c += G;
  for (int i = 0; ; ++i) {
    int pm, pn;
    if (!unit_order((long)i * G + c, nM, nN, pm, pn)) break;
    gemm256_unit(lds, A + (size_t)pm * 256 * lda, lda, Bt + (size_t)pn * 256 * ldb, ldb, K, pm * 256, pn * 2, pre, epi);
  }
}

DI float row_sumsq(const float* rp, int n4) {
  float ss = 0.f;
  for (int j = 0; j < n4; ++j) { f32x4 v = *(const f32x4*)(rp + 4 * j); ss += v[0] * v[0] + v[1] * v[1] + v[2] * v[2] + v[3] * v[3]; }
  return ss;
}
DI void norm_store64(const float* rp, const float* __restrict__ g, float sc, bf16_t* dst, float fsc, float* fdst) {
#pragma unroll
  for (int j = 0; j < 8; ++j) {
    f32x4 v0 = *(const f32x4*)(rp + 8 * j), v1 = *(const f32x4*)(rp + 8 * j + 4);
    f32x4 g0 = *(const f32x4*)(g + 8 * j), g1 = *(const f32x4*)(g + 8 * j + 4);
    f32x4 x0 = v0 * g0, x1 = v1 * g1;
    u32x4 o = {pk2(x0[0] * sc, x0[1] * sc), pk2(x0[2] * sc, x0[3] * sc), pk2(x1[0] * sc, x1[1] * sc), pk2(x1[2] * sc, x1[3] * sc)};
    *(u32x4*)(dst + 8 * j) = o;
    if (fdst) { *(f32x4*)(fdst + 8 * j) = x0 * fsc; *(f32x4*)(fdst + 8 * j + 4) = x1 * fsc; }
  }
}
DI void raw_store64_f32(const float* rp, float* fdst) {
#pragma unroll
  for (int j = 0; j < 16; ++j) *(f32x4*)(fdst + 4 * j) = *(const f32x4*)(rp + 4 * j);
}
DI void raw_store64_bf16(const float* rp, bf16_t* dst) {
#pragma unroll
  for (int j = 0; j < 8; ++j) {
    f32x4 v0 = *(const f32x4*)(rp + 8 * j), v1 = *(const f32x4*)(rp + 8 * j + 4);
    u32x4 o = {pk2(v0[0], v0[1]), pk2(v0[2], v0[3]), pk2(v1[0], v1[1]), pk2(v1[2], v1[3])};
    *(u32x4*)(dst + 8 * j) = o;
  }
}
DI void silu_store64(const float* rp, bf16_t* dst) {
#pragma unroll
  for (int j = 0; j < 8; ++j) {
    f32x4 v0 = *(const f32x4*)(rp + 8 * j), v1 = *(const f32x4*)(rp + 8 * j + 4);
    u32x4 o = {pk2(silu(v0[0]), silu(v0[1])), pk2(silu(v0[2]), silu(v0[3])), pk2(silu(v1[0]), silu(v1[1])), pk2(silu(v1[2]), silu(v1[3]))};
    *(u32x4*)(dst + 8 * j) = o;
  }
}
DI void tr_store64(const float* Cs, int col, int rh, bf16_t* dst) {
#pragma unroll
  for (int g = 0; g < 8; ++g) {
    const float* p = Cs + (rh * 64 + g * 8) * C_STR + col;
    u32x4 o = {pk2(p[0], p[C_STR]), pk2(p[2 * C_STR], p[3 * C_STR]), pk2(p[4 * C_STR], p[5 * C_STR]), pk2(p[6 * C_STR], p[7 * C_STR])};
    *(u32x4*)(dst + g * 8) = o;
  }
}


struct G2 { f32x4 g0, g1; float rv[8]; };
DI G2 load_g2(const float* __restrict__ g, const float* __restrict__ ss = nullptr, int m0 = 0, int t = 0) {
  G2 r; r.g0 = *(const f32x4*)g; r.g1 = *(const f32x4*)(g + 4);
#pragma unroll
  for (int p = 0; p < 8; ++p) r.rv[p] = ss ? ss[m0 + p * 16 + (t >> 4)] : 1024.f * (1.f - EPS);
#pragma unroll
  for (int p = 0; p < 8; ++p) r.rv[p] = rsqrtf(r.rv[p] * (1.f / 1024.f) + EPS);
  return r;
}
template <int LANES> DI float seg_sum(float v) {
#pragma unroll
  for (int o = 1; o < LANES; o <<= 1) v += __shfl_xor(v, o);
  return v;
}
template <int MODE, int SEG, class DB, class DF>
DI void epi_rows(const float* Cs, int t, const G2& gg, float scale, DB dstb, DF dstf) {
  const int rl = t >> 4, c0 = (t & 15) * 8;
  const f32x4 g0 = gg.g0, g1 = gg.g1;
#pragma unroll
  for (int p = 0; p < 8; ++p) {
    const int row = p * 16 + rl;
    f32x4 a = *(const f32x4*)(Cs + row * C_STR + c0) * gg.rv[p], b = *(const f32x4*)(Cs + row * C_STR + c0 + 4) * gg.rv[p];
    float sc = 1.f;
    if (MODE == 1) {
      float ss = a[0] * a[0] + a[1] * a[1] + a[2] * a[2] + a[3] * a[3] + b[0] * b[0] + b[1] * b[1] + b[2] * b[2] + b[3] * b[3];
      ss = seg_sum<SEG / 8>(ss);
      const float rinv = rsqrtf(ss * (1.f / SEG) + EPS);
      a = a * g0 * rinv; b = b * g1 * rinv; sc = scale;
    } else if (MODE == 2) {
#pragma unroll
      for (int k = 0; k < 4; ++k) { a[k] = silu(a[k]); b[k] = silu(b[k]); }
    }
    bf16_t* db = dstb(row, c0);
    if (db) { u32x4 o = {pk2(a[0] * sc, a[1] * sc), pk2(a[2] * sc, a[3] * sc), pk2(b[0] * sc, b[1] * sc), pk2(b[2] * sc, b[3] * sc)}; *(u32x4*)db = o; }
    float* df = dstf(row, c0);
    if (df) { *(f32x4*)df = a; *(f32x4*)(df + 4) = b; }
  }
}
struct NoB { DI bf16_t* operator()(int, int) const { return nullptr; } };
struct NoF { DI float* operator()(int, int) const { return nullptr; } };

struct Ctx {
  const float* const* in;
  float* out;
  unsigned char* ws;
  DI const float* xin_row(int layer, int row) const {
    if (layer == 0) return row < NP ? in[0] + (size_t)row * DM : in[1] + (size_t)(row - NP) * DM;
    return out + (size_t)row * DM;
  }
  template <class T> DI T* wsp(size_t off) const { return (T*)(ws + off); }
};

template <class Perm>
DI void wt_job(const float* __restrict__ W, int K, int N, bf16_t* __restrict__ Wt, int ldw, int Np, Perm perm, long gtid, long gsz) {
  const long items = (long)Np * (K / 8);
  for (long idx = gtid; idx < items; idx += gsz) {
    const int np = (int)(idx % Np), kg = (int)(idx / Np);
    const int n = perm(np);
    u32x4 o = {0u, 0u, 0u, 0u};
    if (n >= 0) {
      const float* p = W + (size_t)(kg * 8) * N + n;
      o = (u32x4){pk2(p[0], p[(size_t)N]), pk2(p[(size_t)2 * N], p[(size_t)3 * N]), pk2(p[(size_t)4 * N], p[(size_t)5 * N]), pk2(p[(size_t)6 * N], p[(size_t)7 * N])};
    }
    *(u32x4*)(Wt + (size_t)np * ldw + kg * 8) = o;
  }
}
__constant__ float ROPE_INV[16] = {1.000000000e+00f, 5.623413324e-01f, 3.162277639e-01f, 1.778279394e-01f, 1.000000015e-01f, 5.623413250e-02f,
                                   3.162277490e-02f, 1.778279431e-02f, 9.999999776e-03f, 5.623413250e-03f, 3.162277630e-03f, 1.778279431e-03f,
                                   1.000000047e-03f, 5.623413017e-04f, 3.162277571e-04f, 1.778279402e-04f};
DI void phase_prep(const Ctx& c) {
  const long gtid = (long)blockIdx.x * NTHR + threadIdx.x, gsz = (long)gridDim.x * NTHR;
  auto ident = [](int n) { return n; };
  for (int j = 0; j < 2; ++j) {
    wt_job(c.in[9] + (size_t)j * 1024 * 4096, 1024, 4096, c.wsp<bf16_t>(WS_WAIN) + (size_t)j * 4096 * LDX, LDX, 4096, ident, gtid, gsz);
    wt_job(c.in[13] + (size_t)j * 1024 * 1024, 1024, 1024, c.wsp<bf16_t>(WS_WAOUT) + (size_t)j * 1024 * LDX, LDX, 1024, ident, gtid, gsz);
  }
  wt_job(c.in[15], 1024, 2560, c.wsp<bf16_t>(WS_WBIN), LDX, 2560, ident, gtid, gsz);
  wt_job(c.in[19], 1024, 1024, c.wsp<bf16_t>(WS_WBOUT), LDX, 1024, ident, gtid, gsz);
  wt_job(c.in[21], 1024, 1824, c.wsp<bf16_t>(WS_WCIN), LDX, 2048, [](int n) { return n < 1024 ? 800 + n : (n < 1824 ? n - 1024 : -1); }, gtid, gsz);
  wt_job(c.in[23], 512, 1536, c.wsp<bf16_t>(WS_WCQB), 512, 1536,
         [](int n) { return n < 1024 ? (n >> 6) * 96 + (n & 63) : ((n - 1024) >> 5) * 96 + 64 + ((n - 1024) & 31); }, gtid, gsz);
  wt_job(c.in[25], 256, 2048, c.wsp<bf16_t>(WS_WCKVB), 256, 2048,
         [](int n) { return n < 1024 ? (n >> 6) * 128 + (n & 63) : ((n - 1024) >> 6) * 128 + 64 + ((n - 1024) & 63); }, gtid, gsz);
  wt_job(c.in[28], 1024, 1024, c.wsp<bf16_t>(WS_WCOUT), LDX, 1024, ident, gtid, gsz);
  float* rope = c.wsp<float>(WS_ROPE);
  for (long idx = gtid; idx < 4096 * 16; idx += gsz) {
    const int pos = (int)(idx >> 4), i = (int)(idx & 15);
    const float ang = (float)pos * ROPE_INV[i];
    const double rev = (double)ang * 0.15915494309189533577;
    const float fr = (float)(rev - floor(rev));
    rope[idx * 2] = __builtin_amdgcn_cosf(fr);
    rope[idx * 2 + 1] = __builtin_amdgcn_sinf(fr);
  }
}

DI void phase_xn(const Ctx& c, int layer, const float* __restrict__ g) {
  const int lane = threadIdx.x & 63;
  const int gw = blockIdx.x * (NTHR / 64) + (threadIdx.x >> 6), nw = gridDim.x * (NTHR / 64);
  bf16_t* xn = c.wsp<bf16_t>(WS_X);
  for (int row = gw; row < NT; row += nw) {
    const float* x = c.xin_row(layer, row);
    f32x4 v[4];
    float ss = 0.f;
#pragma unroll
    for (int i = 0; i < 2; ++i) {
      v[2 * i] = *(const f32x4*)(x + i * 512 + lane * 8);
      v[2 * i + 1] = *(const f32x4*)(x + i * 512 + lane * 8 + 4);
      ss += v[2 * i][0] * v[2 * i][0] + v[2 * i][1] * v[2 * i][1] + v[2 * i][2] * v[2 * i][2] + v[2 * i][3] * v[2 * i][3];
      ss += v[2 * i + 1][0] * v[2 * i + 1][0] + v[2 * i + 1][1] * v[2 * i + 1][1] + v[2 * i + 1][2] * v[2 * i + 1][2] + v[2 * i + 1][3] * v[2 * i + 1][3];
    }
    ss = wave_sum(ss);
    const float rinv = rsqrtf(ss * (1.f / 1024.f) + EPS);
#pragma unroll
    for (int i = 0; i < 2; ++i) {
      f32x4 g0 = *(const f32x4*)(g + i * 512 + lane * 8), g1 = *(const f32x4*)(g + i * 512 + lane * 8 + 4);
      f32x4 a = v[2 * i] * g0 * rinv, b = v[2 * i + 1] * g1 * rinv;
      u32x4 o = {pk2(a[0], a[1]), pk2(a[2], a[3]), pk2(b[0], b[1]), pk2(b[2], b[3])};
      *(u32x4*)(xn + (size_t)row * LDX + i * 512 + lane * 8) = o;
    }
  }
}

DI void conv_cache(const float* __restrict__ ck, const float* __restrict__ cv, bf16_t* __restrict__ Ks, bf16_t* __restrict__ Vts,
                   float* __restrict__ ok, float* __restrict__ ov, int L, int H, int Dh) {
  const long gtid = (long)blockIdx.x * NTHR + threadIdx.x, gsz = (long)gridDim.x * NTHR;
  const int W = H * Dh, W8 = W / 8, LT = L + 64;
  const long nk = (long)SBATCH * L * W8;
  for (long idx = gtid; idx < nk; idx += gsz) {
    const int c8 = (int)(idx % W8); const long br = idx / W8; const int row = (int)(br % L), b = (int)(br / L);
    const float* p = ck + ((size_t)b * L + row) * W + c8 * 8;
    f32x4 a = *(const f32x4*)p, d = *(const f32x4*)(p + 4);
    u32x4 o = {pk2(a[0], a[1]), pk2(a[2], a[3]), pk2(d[0], d[1]), pk2(d[2], d[3])};
    *(u32x4*)(Ks + ((size_t)b * LT + row) * W + c8 * 8) = o;
    if (row >= 64) {
      float* q = ok + ((size_t)b * L + row - 64) * W + c8 * 8;
      *(f32x4*)q = a; *(f32x4*)(q + 4) = d;
    }
    const float* pv = cv + ((size_t)b * L + row) * W + c8 * 8;
    f32x4 va = *(const f32x4*)pv, vd = *(const f32x4*)(pv + 4);
    u32x4 vo = {pk2(va[0], va[1]), pk2(va[2], va[3]), pk2(vd[0], vd[1]), pk2(vd[2], vd[3])};
    *(u32x4*)(Vts + ((size_t)b * LT + row) * W + c8 * 8) = vo;
    if (row >= 64) {
      float* qv = ov + ((size_t)b * L + row - 64) * W + c8 * 8;
      *(f32x4*)qv = va; *(f32x4*)(qv + 4) = vd;
    }
  }
}
DI void conv_cache_c(const Ctx& c) {
  const long gtid = (long)blockIdx.x * NTHR + threadIdx.x, gsz = (long)gridDim.x * NTHR;
  const float* ckv = c.in[6]; const float* ckr = c.in[7];
  bf16_t* CKVs = c.wsp<bf16_t>(WS_CCKVS); bf16_t* KRs = c.wsp<bf16_t>(WS_CKRS);
  const long n1 = (long)SBATCH * PAST * 32;
  for (long idx = gtid; idx < n1; idx += gsz) {
    const int c8 = (int)(idx & 31); const long br = idx >> 5; const int row = (int)(br % PAST), b = (int)(br / PAST);
    const float* p = ckv + ((size_t)b * PAST + row) * 256 + c8 * 8;
    f32x4 a = *(const f32x4*)p, d = *(const f32x4*)(p + 4);
    u32x4 o = {pk2(a[0], a[1]), pk2(a[2], a[3]), pk2(d[0], d[1]), pk2(d[2], d[3])};
    *(u32x4*)(CKVs + ((size_t)b * CKEYS + row) * 256 + c8 * 8) = o;
  }
  const long n2 = (long)SBATCH * PAST * 4;
  for (long idx = gtid; idx < n2; idx += gsz) {
    const int c8 = (int)(idx & 3); const long br = idx >> 2; const int row = (int)(br % PAST), b = (int)(br / PAST);
    const float* p = ckr + ((size_t)b * PAST + row) * 32 + c8 * 8;
    f32x4 a = *(const f32x4*)p, d = *(const f32x4*)(p + 4);
    u32x4 o = {pk2(a[0], a[1]), pk2(a[2], a[3]), pk2(d[0], d[1]), pk2(d[2], d[3])};
    *(u32x4*)(KRs + ((size_t)b * CKEYS + row) * 32 + c8 * 8) = o;
  }
}

DI void phase_gemm_a_in(const Ctx& c, unsigned char* lds, int j, const float* ss) {
  const bf16_t* XN = c.wsp<bf16_t>(WS_X);
  const bf16_t* Wt = c.wsp<bf16_t>(WS_WAIN) + (size_t)j * 4096 * LDX;
  auto pre = [&](int m0, int nt, int t) { return load_g2(((nt >> 3) == 0 ? c.in[10] : c.in[11]) + j * 128 + (t & 15) * 8, ss, m0, t); };
  auto epi = [&](const float* Cs, int m0, int nt, int t, const G2& gg) {
    bf16_t* Q = c.wsp<bf16_t>(WS_AQ); bf16_t* Kp = c.wsp<bf16_t>(WS_AKP); bf16_t* Ks = c.wsp<bf16_t>(WS_AKS);
    bf16_t* Vtp = c.wsp<bf16_t>(WS_AVTP); bf16_t* Vts = c.wsp<bf16_t>(WS_AVTS); bf16_t* SG = c.wsp<bf16_t>(WS_SG);
    const int type = nt >> 3, head = nt & 7;
    const bool prompt = m0 < NP;
    float* out = c.out;
    auto cache_f32 = [&](size_t obase_p, size_t obase_s, int row, int c0) -> float* {
      const int grow = m0 + row;
      if (prompt) { const int b = grow >> 12, sq = grow & 4095; if (sq < SEQ - 512) return nullptr;
        return out + obase_p + ((((size_t)j * PB + b) * 512 + (sq - (SEQ - 512))) * 8 + head) * 128 + c0; }
      const int sr = grow - NP, b = sr >> 6, tt = sr & 63;
      return out + obase_s + ((((size_t)j * SBATCH + b) * 512 + 448 + tt) * 8 + head) * 128 + c0;
    };
    auto kv_bf16 = [&](bf16_t* P_, bf16_t* S_, int row, int c0) -> bf16_t* {
      const int grow = m0 + row;
      if (prompt) return P_ + (size_t)grow * DM + head * 128 + c0;
      const int sr = grow - NP, b = sr >> 6, tt = sr & 63;
      return S_ + ((size_t)b * 576 + 512 + tt) * DM + head * 128 + c0;
    };
    if (type == 0) {
      epi_rows<1, 128>(Cs, t, gg, QS_A, [&](int row, int c0) { return Q + (size_t)(m0 + row) * DM + head * 128 + c0; }, NoF());
    } else if (type == 1) {
      epi_rows<1, 128>(Cs, t, gg, 1.f, [&](int row, int c0) { return kv_bf16(Kp, Ks, row, c0); }, [&](int row, int c0) { return cache_f32(O_AKP, O_AKS, row, c0); });
    } else if (type == 2) {
      epi_rows<0, 128>(Cs, t, gg, 1.f, [&](int row, int c0) { return kv_bf16(Vtp, Vts, row, c0); }, [&](int row, int c0) { return cache_f32(O_AVP, O_AVS, row, c0); });
    } else {
      epi_rows<2, 128>(Cs, t, gg, 1.f, [&](int row, int c0) { return SG + (size_t)(m0 + row) * LDX + head * 128 + c0; }, NoF());
    }
  };
  gemm_units(lds, XN, LDX, Wt, LDX, DM, NT / 256, 16, 0, pre, epi);
}

DI void phase_gemm_b_in(const Ctx& c, unsigned char* lds, const float* ss) {
  const bf16_t* XN = c.wsp<bf16_t>(WS_X);
  const bf16_t* Wt = c.wsp<bf16_t>(WS_WBIN);
  auto pre = [&](int m0, int nt, int t) { return load_g2((nt < 8 ? c.in[16] : c.in[17]) + ((t & 15) * 8 & 63), ss, m0, t); };
  auto epi = [&](const float* Cs, int m0, int nt, int t, const G2& gg) {
    bf16_t* Q = c.wsp<bf16_t>(WS_BQ); bf16_t* Kp = c.wsp<bf16_t>(WS_BKP); bf16_t* Ks = c.wsp<bf16_t>(WS_BKS);
    bf16_t* Vtp = c.wsp<bf16_t>(WS_BVTP); bf16_t* Vts = c.wsp<bf16_t>(WS_BVTS); bf16_t* SG = c.wsp<bf16_t>(WS_SG);
    const bool prompt = m0 < NP;
    float* out = c.out;
    auto cache_f32 = [&](size_t obase_p, size_t obase_s, int hk0, int row, int c0) -> float* {
      const int grow = m0 + row, hk = hk0 + (c0 >> 6), cc = c0 & 63;
      if (prompt) { const int b = grow >> 12, sq = grow & 4095; if (sq < SEQ - 128) return nullptr;
        return out + obase_p + (((size_t)b * 128 + (sq - (SEQ - 128))) * 4 + hk) * 64 + cc; }
      const int sr = grow - NP, b = sr >> 6, tt = sr & 63;
      return out + obase_s + (((size_t)b * 128 + 64 + tt) * 4 + hk) * 64 + cc;
    };
    auto kv_bf16 = [&](bf16_t* P_, bf16_t* S_, int hk0, int row, int c0) -> bf16_t* {
      const int grow = m0 + row;
      if (prompt) return P_ + (size_t)grow * 256 + hk0 * 64 + c0;
      const int sr = grow - NP, b = sr >> 6, tt = sr & 63;
      return S_ + ((size_t)b * 192 + 128 + tt) * 256 + hk0 * 64 + c0;
    };
    if (nt < 8) {
      epi_rows<1, 64>(Cs, t, gg, QS_B, [&](int row, int c0) { return Q + (size_t)(m0 + row) * DM + nt * 128 + c0; }, NoF());
    } else if (nt < 10) {
      const int hk0 = (nt - 8) * 2;
      epi_rows<1, 64>(Cs, t, gg, 1.f, [&](int row, int c0) { return kv_bf16(Kp, Ks, hk0, row, c0); }, [&](int row, int c0) { return cache_f32(O_BKP, O_BKS, hk0, row, c0); });
    } else if (nt < 12) {
      const int hk0 = (nt - 10) * 2;
      epi_rows<0, 64>(Cs, t, gg, 1.f, [&](int row, int c0) { return kv_bf16(Vtp, Vts, hk0, row, c0); }, [&](int row, int c0) { return cache_f32(O_BVP, O_BVS, hk0, row, c0); });
    } else {
      epi_rows<2, 64>(Cs, t, gg, 1.f, [&](int row, int c0) { return SG + (size_t)(m0 + row) * LDX + (nt - 12) * 128 + c0; }, NoF());
    }
  };
  gemm_units(lds, XN, LDX, Wt, LDX, DM, NT / 256, 10, 0, pre, epi);
}

DI void phase_gemm_c_in(const Ctx& c, unsigned char* lds, const float* ss) {
  const bf16_t* XN = c.wsp<bf16_t>(WS_X);
  const bf16_t* Wt = c.wsp<bf16_t>(WS_WCIN);
  auto pre = [&](int m0, int nt, int t) { return load_g2(c.in[20], ss, m0, t); };
  auto epi = [&](const float* Cs, int m0, int nt, int t, const G2& gg) {
    bf16_t* SG = c.wsp<bf16_t>(WS_SG); float* Z = c.wsp<float>(WS_CZ);
    if (nt < 8) {
      epi_rows<2, 128>(Cs, t, gg, 1.f, [&](int row, int c0) { return SG + (size_t)(m0 + row) * LDX + nt * 128 + c0; }, NoF());
    } else {
      const int zc0 = (nt - 8) * 128;
      epi_rows<0, 128>(Cs, t, gg, 1.f, NoB(), [&](int row, int c0) -> float* { return (zc0 + c0 < 800) ? Z + (size_t)(m0 + row) * 800 + zc0 + c0 : nullptr; });
    }
  };
  gemm_units(lds, XN, LDX, Wt, LDX, DM, NT / 256, 8, 0, pre, epi);
}

DI void phase_c_norm(const Ctx& c) {
  const int lane = threadIdx.x & 63;
  const int gw = blockIdx.x * (NTHR / 64) + (threadIdx.x >> 6), nw = gridDim.x * (NTHR / 64);
  const float* Z = c.wsp<float>(WS_CZ);
  bf16_t* QA = c.wsp<bf16_t>(WS_CQA);
  bf16_t* CKVp = c.wsp<bf16_t>(WS_CCKVP); bf16_t* CKVs = c.wsp<bf16_t>(WS_CCKVS);
  bf16_t* KRp = c.wsp<bf16_t>(WS_CKRP); bf16_t* KRs = c.wsp<bf16_t>(WS_CKRS);
  const float* qag = c.in[22]; const float* kvag = c.in[24]; const float* ckg = c.in[27];
  const float* rope = c.wsp<float>(WS_ROPE);
  for (int row = gw; row < NT; row += nw) {
    const float* z = Z + (size_t)row * 800;
    const bool prompt = row < NP;
    int b, s, pos;
    if (prompt) { b = row >> 12; s = row & 4095; pos = s; } else { b = (row - NP) >> 6; s = (row - NP) & 63; pos = PAST + s; }
    {
      f32x4 a = *(const f32x4*)(z + lane * 8), d = *(const f32x4*)(z + lane * 8 + 4);
      float ss = a[0] * a[0] + a[1] * a[1] + a[2] * a[2] + a[3] * a[3] + d[0] * d[0] + d[1] * d[1] + d[2] * d[2] + d[3] * d[3];
      ss = wave_sum(ss);
      const float rinv = rsqrtf(ss * (1.f / 512.f) + EPS);
      f32x4 g0 = *(const f32x4*)(qag + lane * 8), g1 = *(const f32x4*)(qag + lane * 8 + 4);
      a = a * g0 * rinv; d = d * g1 * rinv;
      u32x4 o = {pk2(a[0], a[1]), pk2(a[2], a[3]), pk2(d[0], d[1]), pk2(d[2], d[3])};
      *(u32x4*)(QA + (size_t)row * 512 + lane * 8) = o;
    }
    {
      f32x4 a = *(const f32x4*)(z + 512 + lane * 4);
      float ss = a[0] * a[0] + a[1] * a[1] + a[2] * a[2] + a[3] * a[3];
      ss = wave_sum(ss);
      const float rinv = rsqrtf(ss * (1.f / 256.f) + EPS);
      f32x4 g0 = *(const f32x4*)(kvag + lane * 4);
      a = a * g0 * rinv;
      u32x2 o = {pk2(a[0], a[1]), pk2(a[2], a[3])};
      if (prompt) {
        *(f32x4*)(c.out + O_CKVP + (size_t)row * 256 + lane * 4) = a;
        *(u32x2*)(CKVp + (size_t)row * 256 + lane * 4) = o;
      } else {
        *(f32x4*)(c.out + O_CKVS + ((size_t)b * 64 + s) * 256 + lane * 4) = a;
        *(u32x2*)(CKVs + ((size_t)b * CKEYS + PAST + s) * 256 + lane * 4) = o;
      }
    }
    {
      float v = lane < 32 ? z[768 + lane] : 0.f;
      float ss = wave_sum(v * v);
      const float rinv = rsqrtf(ss * (1.f / 32.f) + EPS);
      const float xn = v * rinv * ckg[64 + (lane & 31)];
      const float other = __shfl_xor(xn, 16);
      const int i = lane & 15;
      const float cs = rope[((size_t)pos * 16 + i) * 2], sn = rope[((size_t)pos * 16 + i) * 2 + 1];
      const float o = (lane & 16) ? (other * sn + xn * cs) : (xn * cs - other * sn);
      if (lane < 32) {
        const unsigned ob = pk2(o, 0.f) & 0xffffu;
        if (prompt) {
          c.out[O_CKRP + (size_t)row * 32 + lane] = o;
          KRp[(size_t)row * 32 + lane] = (bf16_t)ob;
        } else {
          c.out[O_CKRS + ((size_t)b * 64 + s) * 32 + lane] = o;
          KRs[((size_t)b * CKEYS + PAST + s) * 32 + lane] = (bf16_t)ob;
        }
      }
    }
  }
}

DI void c_q_gemm(const Ctx& c, unsigned char* lds, int shift) {
  const bf16_t* QA = c.wsp<bf16_t>(WS_CQA);
  const bf16_t* Wt = c.wsp<bf16_t>(WS_WCQB);
  auto pre = [&](int m0, int nt, int t) { const int c0 = (t & 15) * 8; return load_g2(c.in[26] + (nt < 8 ? (c0 & 63) : 64 + (c0 & 31))); };
  auto epi = [&](const float* Cs, int m0, int nt, int t, const G2& gg) {
  bf16_t* Qc = c.wsp<bf16_t>(WS_CQ);
  const float* rope = c.wsp<float>(WS_ROPE);
  if (nt < 8) {
    epi_rows<1, 64>(Cs, t, gg, QS_C, [&](int row, int c0) { return Qc + (size_t)(m0 + row) * 1536 + (nt * 2 + (c0 >> 6)) * 96 + (c0 & 63); }, NoF());
  } else {
    const int rl = t >> 4, c0 = (t & 15) * 8, hq = c0 >> 5, ci = c0 & 31, i0 = ci & 15;
    const bool isx2 = ci >= 16;
    const f32x4 g0 = gg.g0, g1 = gg.g1;
#pragma unroll 2
    for (int p = 0; p < 8; ++p) {
      const int row = p * 16 + rl, grow = m0 + row;
      f32x4 a = *(const f32x4*)(Cs + row * C_STR + c0), b = *(const f32x4*)(Cs + row * C_STR + c0 + 4);
      float ss = a[0] * a[0] + a[1] * a[1] + a[2] * a[2] + a[3] * a[3] + b[0] * b[0] + b[1] * b[1] + b[2] * b[2] + b[3] * b[3];
      ss = seg_sum<4>(ss);
      const float rinv = rsqrtf(ss * (1.f / 32.f) + EPS);
      a = a * g0 * rinv; b = b * g1 * rinv;
      const int pos = grow < NP ? (grow & 4095) : PAST + ((grow - NP) & 63);
      const float* rt = rope + (size_t)pos * 32 + 2 * i0;
      const f32x4 cs0 = *(const f32x4*)rt, cs1 = *(const f32x4*)(rt + 4), cs2 = *(const f32x4*)(rt + 8), cs3 = *(const f32x4*)(rt + 12);
      const float cv[8] = {cs0[0], cs0[2], cs1[0], cs1[2], cs2[0], cs2[2], cs3[0], cs3[2]};
      const float sv[8] = {cs0[1], cs0[3], cs1[1], cs1[3], cs2[1], cs2[3], cs3[1], cs3[3]};
      float x[8] = {a[0], a[1], a[2], a[3], b[0], b[1], b[2], b[3]}, o[8];
#pragma unroll
      for (int k = 0; k < 8; ++k) {
        const float px = __shfl_xor(x[k], 2);
        o[k] = (isx2 ? (px * sv[k] + x[k] * cv[k]) : (x[k] * cv[k] - px * sv[k])) * QS_C;
      }
      u32x4 ov = {pk2(o[0], o[1]), pk2(o[2], o[3]), pk2(o[4], o[5]), pk2(o[6], o[7])};
      *(u32x4*)(Qc + (size_t)grow * 1536 + ((nt - 8) * 4 + hq) * 96 + 64 + ci) = ov;
    }
  }
  };
  gemm_units(lds, QA, 512, Wt, 512, 512, NT / 256, 6, shift, pre, epi);
}
DI void c_kv_gemm(const Ctx& c, unsigned char* lds, const bf16_t* A, bf16_t* Kn, bf16_t* Vt, int rows_per_b, int nrows, int shift) {
  const bf16_t* Wt = c.wsp<bf16_t>(WS_WCKVB);
  auto pre = [&](int m0, int nt, int t) { return load_g2(c.in[27] + ((t & 15) * 8 & 63)); };
  auto epi = [&](const float* Cs, int m0, int nt, int t, const G2& gg) {
  auto dst = [&](bf16_t* base, int hd0, int row, int c0) -> bf16_t* {
    const int grow = m0 + row, b = grow / rows_per_b, sk = grow - b * rows_per_b;
    return base + (((size_t)b * 16 + hd0 + (c0 >> 6)) * rows_per_b + sk) * 64 + (c0 & 63);
  };
  if (nt < 8) epi_rows<1, 64>(Cs, t, gg, 1.f, [&](int row, int c0) { return dst(Kn, nt * 2, row, c0); }, NoF());
  else        epi_rows<0, 64>(Cs, t, gg, 1.f, [&](int row, int c0) { return dst(Vt, (nt - 8) * 2, row, c0); }, NoF());
  };
  gemm_units(lds, A, 256, Wt, 256, 256, nrows / 256, 8, shift, pre, epi);
}
DI void phase_c_proj(const Ctx& c, unsigned char* lds, int round) {
  bf16_t* Knp = (bf16_t*)(c.out + O_SCR_KNP); bf16_t* Vtp = (bf16_t*)(c.out + O_SCR_VTP);
  if (round == 0) {
    c_q_gemm(c, lds, 0);
    c_kv_gemm(c, lds, c.wsp<bf16_t>(WS_CCKVP), Knp, Vtp, SEQ, NP, 0);
  }
  c_kv_gemm(c, lds, c.wsp<bf16_t>(WS_CCKVS) + (size_t)round * CROUND_B * CKEYS * 256, c.wsp<bf16_t>(WS_CKNS), c.wsp<bf16_t>(WS_CVTS), CKEYS, CROUND_B * CKEYS, 48);
}

DI void phase_gemm_out(const Ctx& c, unsigned char* lds, int layer, const bf16_t* Wt, bool dry, const float* gnext, float* ssnext) {
  const bf16_t* OG = c.wsp<bf16_t>(WS_SG);
  struct X16 { f32x4 x[16]; f32x4 g; };
  auto pre = [&](int m0, int nt, int t) {
    X16 r; const int n0 = nt * 128, rl = t >> 5, c4 = (t & 31) * 4;
#pragma unroll
    for (int p = 0; p < 16; ++p) r.x[p] = *(const f32x4*)(c.xin_row(layer, m0 + p * 8 + rl) + n0 + c4);
    r.g = gnext ? *(const f32x4*)(gnext + n0 + c4) : (f32x4){0.f, 0.f, 0.f, 0.f};
    return r;
  };
  auto epi = [&](const float* Cs, int m0, int nt, int t, const X16& xr) {
    const int n0 = nt * 128, rl = t >> 5, c4 = (t & 31) * 4;
    bf16_t* XG = c.wsp<bf16_t>(WS_X);
#pragma unroll
    for (int p = 0; p < 16; ++p) {
      const int row = p * 8 + rl, grow = m0 + row;
      const f32x4 y = xr.x[p] + *(const f32x4*)(Cs + row * C_STR + c4);
      if (!dry) *(f32x4*)(c.out + (size_t)grow * DM + n0 + c4) = y;
      if (gnext) {
        float ssq = y[0] * y[0] + y[1] * y[1] + y[2] * y[2] + y[3] * y[3];
        ssq = seg_sum<32>(ssq);
        if (!dry) {
          const f32x4 yg = y * xr.g;
          *(u32x2*)(XG + (size_t)grow * LDX + n0 + c4) = (u32x2){pk2(yg[0], yg[1]), pk2(yg[2], yg[3])};
          if ((t & 31) == 0) atomicAdd(ssnext + grow, ssq);
        }
      }
    }
  };
  gemm_units(lds, OG, LDX, Wt, LDX, DM, NT / 256, 4, 0, pre, epi);
}

struct AttnItem {
  const bf16_t* k1; long ks1;
  const bf16_t* k2; long ks2;
  const bf16_t* vt; long vts;
  int t0, t1;
  const bf16_t* qrow;
  long qs;
  bf16_t* og;
  int cw;
  int qi0;
  float bslope;
  float m0, l0;
  bool dry;
};

template <int DQK, int DV, int BIAS, int BAND, int KCH1, bool PIPE>
DI void attn_item(unsigned char* lds, const AttnItem& it) {
  constexpr int KSTR = DQK * 2 + 16, VSTR = DV * 2 + 64;
  constexpr int KBYTES = 64 * KSTR, VBYTES = 64 * VSTR;
  constexpr int KCH = DQK / 8, NKL = 64 * KCH / 256, VCH = DV / 8, NVL = 64 * VCH / 256;
  constexpr int NKS = DQK / 16, NDB = DV / 32;
  static_assert(2 * KBYTES + 2 * VBYTES + 1040 <= ATT_SUB_BYTES, "attn lds");
  int t = threadIdx.x & 255; asm volatile("" : "+v"(t));
  const int lane = t & 63, r = lane & 31, h = lane >> 5;
  unsigned char* Kl = lds; unsigned char* Vl = lds + 2 * KBYTES;
  const float* tab = (const float*)(lds + 2 * KBYTES + 2 * VBYTES);
  bf16x8 qf[NKS];
  {
    const bf16_t* qp = it.qrow + (long)r * it.qs + h * 8;
#pragma unroll
    for (int ks = 0; ks < NKS; ++ks) qf[ks] = *(const bf16x8*)(qp + ks * 16);
  }
  f32x16 o[NDB];
#pragma unroll
  for (int d = 0; d < NDB; ++d) o[d] = f32x16{};
  float m = it.m0, l = it.l0;
  u32x4 kr[NKL]; u32x4 vr[NVL];
  auto gloadK = [&](int tile) {
#pragma unroll
    for (int i = 0; i < NKL; ++i) {
      const int e = t + 256 * i, row = e / KCH, ch = e - row * KCH;
      const long key = (long)tile * 64 + row;
      const bf16_t* src = (ch < KCH1) ? it.k1 + key * it.ks1 + ch * 8 : it.k2 + key * it.ks2 + (ch - KCH1) * 8;
      kr[i] = *(const u32x4*)src;
    }
  };
  auto gloadV = [&](int tile) {
#pragma unroll
    for (int i = 0; i < NVL; ++i) {
      const int e = t + 256 * i, row = e / VCH, ch = e - row * VCH;
      vr[i] = *(const u32x4*)(it.vt + ((long)tile * 64 + row) * it.vts + ch * 8);
    }
  };
  auto lwriteK = [&](int buf) {
#pragma unroll
    for (int i = 0; i < NKL; ++i) {
      const int e = t + 256 * i, row = e / KCH, ch = e - row * KCH;
      *(u32x4*)(Kl + buf * KBYTES + row * KSTR + ch * 16) = kr[i];
    }
  };
  auto lwriteV = [&](int buf) {
#pragma unroll
    for (int i = 0; i < NVL; ++i) {
      const int e = t + 256 * i, row = e / VCH, ch = e - row * VCH;
      *(u32x4*)(Vl + buf * VBYTES + row * VSTR + ch * 16) = vr[i];
    }
  };
  auto is_active = [&](int tile) { return (tile <= it.cw) && (tile >= it.cw - (BAND - 1)); };
  auto qk = [&](int tile, int buf, f32x16& s0, f32x16& s1) {
    const int dt = it.cw - tile;
    const int dbase = dt * 64 + it.qi0 + r - 4 * h;
    if (BIAS == 1) {
      if (dt >= 3) { const float cb = tab[256];
#pragma unroll
        for (int i = 0; i < 16; ++i) { s0[i] = cb; s1[i] = cb; }
      } else {
#pragma unroll
        for (int i = 0; i < 16; ++i) {
          const int d0 = dbase - ((i & 3) + 8 * (i >> 2));
          s0[i] = tab[min(max(d0, -128), 128) + 128];
          s1[i] = tab[min(max(d0 - 32, -128), 128) + 128];
        }
      }
    } else if (BIAS == 2) {
#pragma unroll
      for (int i = 0; i < 16; ++i) {
        const int d0 = dbase - ((i & 3) + 8 * (i >> 2));
        s0[i] = -it.bslope * fabsf((float)d0);
        s1[i] = -it.bslope * fabsf((float)(d0 - 32));
      }
    } else {
#pragma unroll
      for (int i = 0; i < 16; ++i) { s0[i] = 0.f; s1[i] = 0.f; }
    }
    const unsigned char* kb = Kl + buf * KBYTES + r * KSTR + h * 16;
#pragma unroll
    for (int ks = 0; ks < NKS; ++ks) {
      bf16x8 k0 = *(const bf16x8*)(kb + ks * 32);
      bf16x8 k1 = *(const bf16x8*)(kb + 32 * KSTR + ks * 32);
      s0 = MFMA(k0, qf[ks], s0);
      s1 = MFMA(k1, qf[ks], s1);
    }
  };
  auto softmax_pv = [&](int buf, f32x16& s0, f32x16& s1) {
    float mx = s0[0];
#pragma unroll
    for (int i = 1; i < 16; ++i) mx = fmaxf(mx, s0[i]);
#pragma unroll
    for (int i = 0; i < 16; ++i) mx = fmaxf(mx, s1[i]);
    mx = half_max(mx);
    const float mn = fmaxf(m, mx);
    const float alpha = fast_exp2(m - mn);
    const bool resc = __any(mn > m);
    m = mn;
    float rs = 0.f;
#pragma unroll
    for (int i = 0; i < 16; ++i) { s0[i] = fast_exp2(s0[i] - mn); s1[i] = fast_exp2(s1[i] - mn); rs += s0[i] + s1[i]; }
    rs = half_sum(rs);
    l = l * alpha + rs;
    if (resc) {
#pragma unroll
      for (int d = 0; d < NDB; ++d)
#pragma unroll
        for (int i = 0; i < 16; ++i) o[d][i] *= alpha;
    }
    bf16x8 pf[4];
    {
      u32x4 a = {pk2(s0[0], s0[1]), pk2(s0[2], s0[3]), pk2(s0[4], s0[5]), pk2(s0[6], s0[7])};
      u32x4 b = {pk2(s0[8], s0[9]), pk2(s0[10], s0[11]), pk2(s0[12], s0[13]), pk2(s0[14], s0[15])};
      u32x4 cc = {pk2(s1[0], s1[1]), pk2(s1[2], s1[3]), pk2(s1[4], s1[5]), pk2(s1[6], s1[7])};
      u32x4 dd = {pk2(s1[8], s1[9]), pk2(s1[10], s1[11]), pk2(s1[12], s1[13]), pk2(s1[14], s1[15])};
      pf[0] = __builtin_bit_cast(bf16x8, a); pf[1] = __builtin_bit_cast(bf16x8, b);
      pf[2] = __builtin_bit_cast(bf16x8, cc); pf[3] = __builtin_bit_cast(bf16x8, dd);
    }
    const LAS unsigned char* vb = (const LAS unsigned char*)(Vl + buf * VBYTES) + (4 * h + ((lane & 15) >> 2)) * VSTR + (16 * ((lane >> 4) & 1) + 4 * (lane & 3)) * 2;
#pragma unroll
    for (int kk = 0; kk < 4; ++kk) {
#pragma unroll
      for (int d = 0; d < NDB; ++d) {
        const LAS unsigned char* p = vb + kk * 16 * VSTR + d * 64;
        s16x4 lo = __builtin_amdgcn_ds_read_tr16_b64_v4i16((LAS s16x4*)p);
        s16x4 hi = __builtin_amdgcn_ds_read_tr16_b64_v4i16((LAS s16x4*)(p + 8 * VSTR));
        bf16x8 vf = {lo[0], lo[1], lo[2], lo[3], hi[0], hi[1], hi[2], hi[3]};
        o[d] = MFMA(vf, pf[kk], o[d]);
      }
    }
  };
  const int ntile = it.t1 - it.t0 + 1;
  if (!PIPE) {
    gloadK(it.t0); gloadV(it.t0);
    __syncthreads();
    lwriteK(0); lwriteV(0);
    __syncthreads();
    for (int jt = 0; jt < ntile; ++jt) {
      const int buf = jt & 1, tile = it.t0 + jt;
      if (jt + 1 < ntile) { gloadK(tile + 1); gloadV(tile + 1); }
      if (is_active(tile)) {
        f32x16 s0, s1;
        qk(tile, buf, s0, s1);
        softmax_pv(buf, s0, s1);
      }
      if (jt + 1 < ntile) { lwriteK(buf ^ 1); lwriteV(buf ^ 1); }
      __syncthreads();
    }
  } else {
    f32x16 c0, c1, n0, n1;
    gloadK(it.t0); gloadV(it.t0);
    __syncthreads();
    lwriteK(0); lwriteV(0);
    if (ntile > 1) { gloadK(it.t0 + 1); lwriteK(1); }
    __syncthreads();
    if (is_active(it.t0)) qk(it.t0, 0, c0, c1);
    __syncthreads();
    for (int jt = 0; jt < ntile; ++jt) {
      const int buf = jt & 1, tile = it.t0 + jt;
      if (jt + 2 < ntile) gloadK(tile + 2);
      if (jt + 1 < ntile) gloadV(tile + 1);
      if (jt + 1 < ntile && is_active(tile + 1)) qk(tile + 1, buf ^ 1, n0, n1);
      if (is_active(tile)) softmax_pv(buf, c0, c1);
      if (jt + 2 < ntile) lwriteK(buf);
      if (jt + 1 < ntile) lwriteV(buf ^ 1);
      __syncthreads();
      c0 = n0; c1 = n1;
    }
  }
  if (it.cw >= 0 && !it.dry) {
    const float linv = 1.f / l;
    constexpr int ROWB = DV * 2 + 16, CPR = DV / 8, RPP = 64 / CPR;
    unsigned char* Ol = lds + (t >> 6) * (32 * ROWB);
#pragma unroll
    for (int d = 0; d < NDB; ++d) {
#pragma unroll
      for (int g = 0; g < 4; ++g) {
        u32x2 v = {pk2(o[d][4 * g] * linv, o[d][4 * g + 1] * linv), pk2(o[d][4 * g + 2] * linv, o[d][4 * g + 3] * linv)};
        *(u32x2*)(Ol + r * ROWB + (d * 32 + 8 * g + 4 * h) * 2) = v;
      }
    }
    const int rrow = lane / CPR, ch = lane % CPR;
#pragma unroll
    for (int p = 0; p < 32 / RPP; ++p) {
      const int row = p * RPP + rrow;
      const u32x4 ov = *(const u32x4*)(Ol + row * ROWB + ch * 16);
      bf16_t* gp = it.og + (long)row * LDX + ch * 8;
      const u32x4 sg = *(const u32x4*)gp;
      u32x4 res;
#pragma unroll
      for (int k = 0; k < 4; ++k) res[k] = pk2(bf_lo(ov[k]) * bf_lo(sg[k]), bf_hi(ov[k]) * bf_hi(sg[k]));
      *(u32x4*)gp = res;
    }
  }
}

template <int DQK, int DV, int KCH1>
DI void attn_wide(unsigned char* lds, const AttnItem& it) {
  constexpr int KSTR = DQK * 2 + 16, VSTR = DV * 2 + 64;
  constexpr int KBYTES = 128 * KSTR, VBYTES = 128 * VSTR;
  constexpr int KCH = DQK / 8, VCH = DV / 8;
  static_assert((128 * KCH) % NTHR == 0 && (128 * VCH) % NTHR == 0, "staging split");
  constexpr int NKL = 128 * KCH / NTHR, NVL = 128 * VCH / NTHR;
  constexpr int NKS = DQK / 16, NDB = DV / 32;
  static_assert(2 * KBYTES + 2 * VBYTES <= LDS_BYTES, "attn_wide lds");
  int t = threadIdx.x; asm volatile("" : "+v"(t));
  const int lane = t & 63, r = lane & 31, h = lane >> 5;
  unsigned char* Kl = lds; unsigned char* Vl = lds + 2 * KBYTES;
  bf16x8 qf[NKS];
  {
    const bf16_t* qp = it.qrow + (long)r * it.qs + h * 8;
#pragma unroll
    for (int ks = 0; ks < NKS; ++ks) qf[ks] = *(const bf16x8*)(qp + ks * 16);
  }
  f32x16 o[NDB];
#pragma unroll
  for (int d = 0; d < NDB; ++d) o[d] = f32x16{};
  float m = it.m0, l = it.l0;
  u32x4 kr[NKL]; u32x4 vr[NVL];
  auto gload = [&](int step) {
#pragma unroll
    for (int i = 0; i < NKL; ++i) {
      const int e = t + NTHR * i, row = e / KCH, ch = e - row * KCH;
      const long key = (long)step * 128 + row;
      const bf16_t* src = (ch < KCH1) ? it.k1 + key * it.ks1 + ch * 8 : it.k2 + key * it.ks2 + (ch - KCH1) * 8;
      kr[i] = *(const u32x4*)src;
    }
#pragma unroll
    for (int i = 0; i < NVL; ++i) {
      const int e = t + NTHR * i, row = e / VCH, ch = e - row * VCH;
      vr[i] = *(const u32x4*)(it.vt + ((long)step * 128 + row) * it.vts + ch * 8);
    }
  };
  auto lwrite = [&](int buf) {
#pragma unroll
    for (int i = 0; i < NKL; ++i) {
      const int e = t + NTHR * i, row = e / KCH, ch = e - row * KCH;
      *(u32x4*)(Kl + buf * KBYTES + row * KSTR + ch * 16) = kr[i];
    }
#pragma unroll
    for (int i = 0; i < NVL; ++i) {
      const int e = t + NTHR * i, row = e / VCH, ch = e - row * VCH;
      *(u32x4*)(Vl + buf * VBYTES + row * VSTR + ch * 16) = vr[i];
    }
  };
  auto qk = [&](int st, int buf, f32x16& s0, f32x16& s1) {
#pragma unroll
    for (int i = 0; i < 16; ++i) { s0[i] = 0.f; s1[i] = 0.f; }
    const unsigned char* kb = Kl + buf * KBYTES + (st * 64 + r) * KSTR + h * 16;
#pragma unroll
    for (int ks = 0; ks < NKS; ++ks) {
      bf16x8 k0 = *(const bf16x8*)(kb + ks * 32);
      bf16x8 k1 = *(const bf16x8*)(kb + 32 * KSTR + ks * 32);
      s0 = MFMA(k0, qf[ks], s0);
      s1 = MFMA(k1, qf[ks], s1);
    }
  };
  auto softmax_pv = [&](int st, int buf, f32x16& s0, f32x16& s1) {
    float mx = s0[0];
#pragma unroll
    for (int i = 1; i < 16; ++i) mx = fmaxf(mx, s0[i]);
#pragma unroll
    for (int i = 0; i < 16; ++i) mx = fmaxf(mx, s1[i]);
    mx = half_max(mx);
    const float mn = fmaxf(m, mx);
    const float alpha = fast_exp2(m - mn);
    const bool resc = __any(mn > m);
    m = mn;
    float rs = 0.f;
#pragma unroll
    for (int i = 0; i < 16; ++i) { s0[i] = fast_exp2(s0[i] - mn); s1[i] = fast_exp2(s1[i] - mn); rs += s0[i] + s1[i]; }
    rs = half_sum(rs);
    l = l * alpha + rs;
    if (resc) {
#pragma unroll
      for (int d = 0; d < NDB; ++d)
#pragma unroll
        for (int i = 0; i < 16; ++i) o[d][i] *= alpha;
    }
    bf16x8 pf[4];
    {
      u32x4 a = {pk2(s0[0], s0[1]), pk2(s0[2], s0[3]), pk2(s0[4], s0[5]), pk2(s0[6], s0[7])};
      u32x4 b = {pk2(s0[8], s0[9]), pk2(s0[10], s0[11]), pk2(s0[12], s0[13]), pk2(s0[14], s0[15])};
      u32x4 cc = {pk2(s1[0], s1[1]), pk2(s1[2], s1[3]), pk2(s1[4], s1[5]), pk2(s1[6], s1[7])};
      u32x4 dd = {pk2(s1[8], s1[9]), pk2(s1[10], s1[11]), pk2(s1[12], s1[13]), pk2(s1[14], s1[15])};
      pf[0] = __builtin_bit_cast(bf16x8, a); pf[1] = __builtin_bit_cast(bf16x8, b);
      pf[2] = __builtin_bit_cast(bf16x8, cc); pf[3] = __builtin_bit_cast(bf16x8, dd);
    }
    const LAS unsigned char* vb = (const LAS unsigned char*)(Vl + buf * VBYTES) + (st * 64 + 4 * h + ((lane & 15) >> 2)) * VSTR + (16 * ((lane >> 4) & 1) + 4 * (lane & 3)) * 2;
#pragma unroll
    for (int kk = 0; kk < 4; ++kk) {
#pragma unroll
      for (int d = 0; d < NDB; ++d) {
        const LAS unsigned char* p = vb + kk * 16 * VSTR + d * 64;
        s16x4 lo = __builtin_amdgcn_ds_read_tr16_b64_v4i16((LAS s16x4*)p);
        s16x4 hi = __builtin_amdgcn_ds_read_tr16_b64_v4i16((LAS s16x4*)(p + 8 * VSTR));
        bf16x8 vf = {lo[0], lo[1], lo[2], lo[3], hi[0], hi[1], hi[2], hi[3]};
        o[d] = MFMA(vf, pf[kk], o[d]);
      }
    }
  };
  const int nstep = (it.t1 + 1) >> 1;
  gload(0);
  __syncthreads();
  lwrite(0);
  __syncthreads();
  for (int js = 0; js < nstep; ++js) {
    const int buf = js & 1;
    if (js + 1 < nstep) gload(js + 1);
    const bool a0 = 2 * js <= it.cw, a1 = 2 * js + 1 <= it.cw;
    f32x16 c0, c1, n0, n1;
    if (a0) qk(0, buf, c0, c1);
    if (a1) qk(1, buf, n0, n1);
    if (a0) softmax_pv(0, buf, c0, c1);
    if (a1) softmax_pv(1, buf, n0, n1);
    if (js + 1 < nstep) lwrite(buf ^ 1);
    __syncthreads();
  }
  if (!it.dry) {
    const float linv = 1.f / l;
    constexpr int ROWB = DV * 2 + 16, CPR = DV / 8, RPP = 64 / CPR;
    unsigned char* Ol = lds + (t >> 6) * (32 * ROWB);
#pragma unroll
    for (int d = 0; d < NDB; ++d) {
#pragma unroll
      for (int g = 0; g < 4; ++g) {
        u32x2 v = {pk2(o[d][4 * g] * linv, o[d][4 * g + 1] * linv), pk2(o[d][4 * g + 2] * linv, o[d][4 * g + 3] * linv)};
        *(u32x2*)(Ol + r * ROWB + (d * 32 + 8 * g + 4 * h) * 2) = v;
      }
    }
    const int rrow = lane / CPR, ch = lane % CPR;
#pragma unroll
    for (int p = 0; p < 32 / RPP; ++p) {
      const int row = p * RPP + rrow;
      const u32x4 ov = *(const u32x4*)(Ol + row * ROWB + ch * 16);
      bf16_t* gp = it.og + (long)row * LDX + ch * 8;
      const u32x4 sg = *(const u32x4*)gp;
      u32x4 res;
#pragma unroll
      for (int k = 0; k < 4; ++k) res[k] = pk2(bf_lo(ov[k]) * bf_lo(sg[k]), bf_hi(ov[k]) * bf_hi(sg[k]));
      *(u32x4*)gp = res;
    }
  }
}

DI void phase_attn_a(const Ctx& c, unsigned char* lds0, int j, bool dry) {
  const int w = __builtin_amdgcn_readfirstlane(threadIdx.x >> 6) & 3, sub = __builtin_amdgcn_readfirstlane(threadIdx.x >> 8);
  unsigned char* lds = lds0 + sub * ATT_SUB_BYTES;
  const bf16_t* Q = c.wsp<bf16_t>(WS_AQ); const bf16_t* Kp = c.wsp<bf16_t>(WS_AKP); const bf16_t* Ks = c.wsp<bf16_t>(WS_AKS);
  const bf16_t* Vtp = c.wsp<bf16_t>(WS_AVTP); const bf16_t* Vts = c.wsp<bf16_t>(WS_AVTS); bf16_t* SG = c.wsp<bf16_t>(WS_SG);
  const float* rel = c.in[12] + (size_t)j * 8 * 257;
  float* tab = (float*)(lds + 2 * 64 * (128 * 2 + 16) + 2 * 64 * (128 * 2 + 64));
  const int nitems = 2048 + 256;
  for (int pair = blockIdx.x; pair * 2 < nitems; pair += gridDim.x) {
    const int item = pair * 2 + sub;
    AttnItem it;
    int hh;
    if (item < 2048) {
      const int p = item >> 6, bh = item & 63, b = bh >> 3; hh = bh & 7;
      const int c0 = 2 * p;
      it.k1 = Kp + (size_t)b * SEQ * DM + hh * 128; it.ks1 = DM;
      it.vt = Vtp + (size_t)b * SEQ * DM + hh * 128; it.vts = DM;
      it.t0 = c0 - 8 > 0 ? c0 - 8 : 0; it.t1 = c0 + 1;
      it.cw = c0 + (w >> 1); it.qi0 = (w & 1) * 32;
      const size_t tok = (size_t)b * SEQ + it.cw * 64 + it.qi0;
      it.qrow = Q + tok * DM + hh * 128; it.og = SG + tok * LDX + hh * 128;
    } else {
      const int u = item - 2048, b = u >> 3; hh = u & 7;
      it.k1 = Ks + (size_t)b * 576 * DM + hh * 128; it.ks1 = DM;
      it.vt = Vts + (size_t)b * 576 * DM + hh * 128; it.vts = DM;
      it.t0 = 0; it.t1 = 8;
      it.cw = w < 2 ? 8 : -1000; it.qi0 = (w & 1) * 32;
      const size_t tok = (size_t)NP + b * 64 + it.qi0;
      it.qrow = Q + tok * DM + hh * 128; it.og = SG + tok * LDX + hh * 128;
    }
    it.k2 = it.k1; it.ks2 = 0; it.qs = DM; it.bslope = 0.f; it.m0 = -1e30f; it.l0 = 0.f; it.dry = dry;
    __syncthreads();
    for (int i = threadIdx.x & 255; i < 257; i += 256) tab[i] = rel[hh * 257 + i] * LOG2E;
    attn_item<128, 128, 1, 9, 16, false>(lds, it);
  }
}
DI void phase_attn_b(const Ctx& c, unsigned char* lds0, bool dry) {
  const int w = __builtin_amdgcn_readfirstlane(threadIdx.x >> 6) & 3, sub = __builtin_amdgcn_readfirstlane(threadIdx.x >> 8);
  unsigned char* lds = lds0 + sub * ATT_SUB_BYTES;
  const bf16_t* Q = c.wsp<bf16_t>(WS_BQ); const bf16_t* Kp = c.wsp<bf16_t>(WS_BKP); const bf16_t* Ks = c.wsp<bf16_t>(WS_BKS);
  const bf16_t* Vtp = c.wsp<bf16_t>(WS_BVTP); const bf16_t* Vts = c.wsp<bf16_t>(WS_BVTS); bf16_t* SG = c.wsp<bf16_t>(WS_SG);
  const float* sinks = c.in[18];
  const int nitems = 4096 + 256;
  for (int pair = blockIdx.x; pair * 2 < nitems; pair += gridDim.x) {
    const int item = pair * 2 + sub;
    AttnItem it;
    int head;
    if (item < 4096) {
      const int gp = item & 1, hk = (item >> 1) & 3, cc = (item >> 3) & 63, b = item >> 9;
      head = hk * 4 + gp * 2 + (w >> 1);
      it.k1 = Kp + (size_t)b * SEQ * 256 + hk * 64; it.ks1 = 256;
      it.vt = Vtp + (size_t)b * SEQ * 256 + hk * 64; it.vts = 256;
      it.t0 = cc - 2 > 0 ? cc - 2 : 0; it.t1 = cc;
      it.cw = cc; it.qi0 = (w & 1) * 32;
      const size_t tok = (size_t)b * SEQ + cc * 64 + it.qi0;
      it.qrow = Q + tok * DM + head * 64; it.og = SG + tok * LDX + head * 64;
    } else {
      const int u = item - 4096, gp = u & 1, hk = (u >> 1) & 3, b = u >> 3;
      head = hk * 4 + gp * 2 + (w >> 1);
      it.k1 = Ks + (size_t)b * 192 * 256 + hk * 64; it.ks1 = 256;
      it.vt = Vts + (size_t)b * 192 * 256 + hk * 64; it.vts = 256;
      it.t0 = 0; it.t1 = 2;
      it.cw = 2; it.qi0 = (w & 1) * 32;
      const size_t tok = (size_t)NP + b * 64 + it.qi0;
      it.qrow = Q + tok * DM + head * 64; it.og = SG + tok * LDX + head * 64;
    }
    it.k2 = it.k1; it.ks2 = 0; it.qs = DM;
    it.bslope = exp2f(-0.5f * (float)(head + 1)) * LOG2E;
    it.m0 = sinks[head] * LOG2E; it.l0 = 1.f; it.dry = dry;
    attn_item<64, 64, 2, 3, 8, true>(lds, it);
  }
}
DI void phase_attn_c(const Ctx& c, unsigned char* lds0, int round, bool dry) {
  const int w = __builtin_amdgcn_readfirstlane(threadIdx.x >> 6) & 3, sub = __builtin_amdgcn_readfirstlane(threadIdx.x >> 8);
  unsigned char* lds = lds0 + sub * ATT_SUB_BYTES;
  const bf16_t* Qc = c.wsp<bf16_t>(WS_CQ); bf16_t* SG = c.wsp<bf16_t>(WS_SG);
  const bf16_t* Knp = (const bf16_t*)(c.out + O_SCR_KNP); const bf16_t* Vtp = (const bf16_t*)(c.out + O_SCR_VTP);
  const bf16_t* KRp = c.wsp<bf16_t>(WS_CKRP); const bf16_t* KRs = c.wsp<bf16_t>(WS_CKRS);
  const bf16_t* Kns = c.wsp<bf16_t>(WS_CKNS); const bf16_t* Vts = c.wsp<bf16_t>(WS_CVTS);
  const int w8 = __builtin_amdgcn_readfirstlane(threadIdx.x >> 6);
  const int nquad = round == 0 ? 2048 : 0, nsamp = CROUND_B * 16 / 2, nent = nquad + nsamp;
  unsigned* ctr = (unsigned*)(c.ws + WS_CTL) + 3520 + 64 * (round + (dry ? 2 : 0));
  volatile LAS unsigned* slot = (volatile LAS unsigned*)((LAS unsigned char*)lds0 + LDS_BYTES + 8);
  unsigned nxt = 0;
  if (threadIdx.x == 0) nxt = __hip_atomic_fetch_add(ctr, 1u, __ATOMIC_RELAXED, __HIP_MEMORY_SCOPE_AGENT);
  for (;;) {
    __syncthreads();
    if (threadIdx.x == 0) *slot = nxt;
    __syncthreads();
    const int ent = (int)*slot;
    if (ent >= nent) break;
    if (threadIdx.x == 0) nxt = __hip_atomic_fetch_add(ctr, 1u, __ATOMIC_RELAXED, __HIP_MEMORY_SCOPE_AGENT);
    const int nhead = nquad / 2;
    AttnItem it;
    it.qs = 1536; it.bslope = 0.f; it.m0 = -1e30f; it.l0 = 0.f; it.dry = dry;
    if (ent < nhead || ent >= nhead + nsamp) {
      const int qd = ent < nhead ? ent : ent - nsamp;
      const int q4 = 15 - (qd >> 7), bh = qd & 127, b = bh >> 4, hh = bh & 15;
      it.k1 = Knp + ((size_t)b * 16 + hh) * SEQ * 64; it.ks1 = 64;
      it.k2 = KRp + (size_t)b * SEQ * 32; it.ks2 = 32;
      it.vt = Vtp + ((size_t)b * 16 + hh) * SEQ * 64; it.vts = 64;
      it.t0 = 0; it.t1 = 4 * q4 + 3;
      it.cw = 4 * q4 + (w8 >> 1); it.qi0 = (w8 & 1) * 32;
      const size_t tok = (size_t)b * SEQ + it.cw * 64 + it.qi0;
      it.qrow = Qc + tok * 1536 + hh * 96; it.og = SG + tok * LDX + hh * 64;
      attn_wide<96, 64, 8>(lds0, it);
      continue;
    }
    {
      const int item = (ent - nhead) * 2 + sub;
      {
      const int u = item, bl = u >> 4, hh = u & 15, b = round * CROUND_B + bl;
      it.k1 = Kns + ((size_t)bl * 16 + hh) * CKEYS * 64; it.ks1 = 64;
      it.k2 = KRs + (size_t)b * CKEYS * 32; it.ks2 = 32;
      it.vt = Vts + ((size_t)bl * 16 + hh) * CKEYS * 64; it.vts = 64;
      it.t0 = 0; it.t1 = 32;
      it.cw = w < 2 ? 32 : -1000; it.qi0 = (w & 1) * 32;
      const size_t tok = (size_t)NP + b * 64 + it.qi0;
      it.qrow = Qc + tok * 1536 + hh * 96; it.og = SG + tok * LDX + hh * 64;
    }
    attn_item<96, 64, 0, 100000, 8, true>(lds, it);
    }

  }
}

constexpr int N_PHASES = 20;
__global__ void __launch_bounds__(NTHR, 2) mega(Params P) {
  __shared__ __attribute__((aligned(16))) unsigned char lds[LDS_BYTES + 16];
  Ctx c{P.in, P.out, P.ws};
  const int lo = P.ph_lo, hi = P.ph_hi;
#if MODE_COOP
  if (threadIdx.x < 4) ((volatile LAS unsigned*)(lds + LDS_BYTES))[threadIdx.x] = 0u;
  __syncthreads();
  XcdBarrier xbar = xcd_barrier_post((unsigned*)(P.ws + WS_CTL), (volatile LAS unsigned*)(lds + LDS_BYTES));
  if (P.ph_lo < 0) cg::this_grid().sync();
#endif
#define IN(k) (lo <= (k) && (k) < hi)
#if MODE_COOP
#define SEAM(k) do { if (IN(k) && IN((k) + 1)) xcd_barrier(xbar); } while (0)
#else
#define SEAM(k) do { } while (0)
#endif
  const bool dryf = P.ph_lo >= 0;
#define RUN(k, ...) do { if (IN(k)) { if ((PROBE_DUP >> (k)) & 1u) { const bool dry = dryf; __VA_ARGS__; } { const bool dry = false; __VA_ARGS__; } } SEAM(k); } while (0)
  RUN(0, (void)dry; phase_prep(c); phase_xn(c, 0, c.in[8]);
         conv_cache(c.in[2], c.in[3], c.wsp<bf16_t>(WS_AKS), c.wsp<bf16_t>(WS_AVTS), c.out + O_AKS, c.out + O_AVS, 512, 8, 128));
  float* SS = c.wsp<float>(WS_SS);
  RUN(1, (void)dry; phase_gemm_a_in(c, lds, 0, nullptr));
  RUN(2, phase_attn_a(c, lds, 0, dry));
  RUN(3, phase_gemm_out(c, lds, 0, c.wsp<bf16_t>(WS_WAOUT), dry, c.in[14], SS));
  RUN(4, (void)dry;
         conv_cache(c.in[4], c.in[5], c.wsp<bf16_t>(WS_BKS), c.wsp<bf16_t>(WS_BVTS), c.out + O_BKS, c.out + O_BVS, 128, 4, 64));
  RUN(5, (void)dry; phase_gemm_b_in(c, lds, SS));
  RUN(6, phase_attn_b(c, lds, dry));
  RUN(7, phase_gemm_out(c, lds, 1, c.wsp<bf16_t>(WS_WBOUT), dry, c.in[20], SS + NT));
  RUN(9, (void)dry; phase_gemm_c_in(c, lds, SS + NT));
  RUN(10, (void)dry; phase_c_norm(c); conv_cache_c(c));
  RUN(11, (void)dry; phase_c_proj(c, lds, 0));
  RUN(12, phase_attn_c(c, lds, 0, dry));
  RUN(13, (void)dry; phase_c_proj(c, lds, 1));
  RUN(14, phase_attn_c(c, lds, 1, dry));
  RUN(15, phase_gemm_out(c, lds, 2, c.wsp<bf16_t>(WS_WCOUT), dry, c.in[8] + 1024, SS + 2 * NT));
  RUN(16, (void)dry;
          conv_cache(c.in[2] + (size_t)SBATCH * 512 * 1024, c.in[3] + (size_t)SBATCH * 512 * 1024, c.wsp<bf16_t>(WS_AKS), c.wsp<bf16_t>(WS_AVTS),
                     c.out + O_AKS + 16777216, c.out + O_AVS + 16777216, 512, 8, 128));
  RUN(17, (void)dry; phase_gemm_a_in(c, lds, 1, SS + 2 * NT));
  RUN(18, phase_attn_a(c, lds, 1, dry));
  RUN(19, phase_gemm_out(c, lds, 3, c.wsp<bf16_t>(WS_WAOUT) + (size_t)1024 * LDX, dry, nullptr, nullptr));
#undef RUN
#undef IN
#undef SEAM
}

extern "C" void kernel_launch(void* const* d_in, const int* in_sizes, int n_in, void* d_out, int out_size, void* d_ws, size_t ws_size, hipStream_t stream) {
  static int grid = 0;
  if (grid == 0) {
    if (n_in != 29 || (size_t)out_size != O_END || ws_size < WS_NEED) {
      fprintf(stderr, "kernel_launch: unexpected shapes: n_in %d out %d ws %zu (need %zu)\n", n_in, out_size, ws_size, (size_t)WS_NEED);
      grid = -1; return;
    }
    int dev = 0, cus = 0, per_cu = 0;
    hipGetDevice(&dev);
    hipDeviceGetAttribute(&cus, hipDeviceAttributeMultiprocessorCount, dev);
    hipOccupancyMaxActiveBlocksPerMultiprocessor(&per_cu, (const void*)mega, NTHR, 0);
    if (per_cu < 1) { fprintf(stderr, "kernel_launch: occupancy query returned %d\n", per_cu); grid = -1; return; }
    per_cu = 1;
    grid = cus * per_cu;
    fprintf(stderr, "kernel_launch: grid %d (%d CUs x %d)\n", grid, cus, per_cu);
  }
  if (grid < 0) return;
  Params p{};
  for (int i = 0; i < 29; ++i) p.in[i] = (const float*)d_in[i];
  p.out = (float*)d_out; p.ws = (unsigned char*)d_ws;
#if MODE_COOP
  if (hipMemsetAsync((char*)d_ws + WS_CTL, 0, WS_CTL_BYTES, stream) != hipSuccess) { fprintf(stderr, "kernel_launch: memset failed\n"); return; }
  p.ph_lo = 0; p.ph_hi = N_PHASES;
  void* args[] = {&p};
  hipError_t e = hipLaunchCooperativeKernel((const void*)mega, dim3(grid), dim3(NTHR), args, 0, stream);
  if (e != hipSuccess) fprintf(stderr, "cooperative launch failed: %s (grid %d)\n", hipGetErrorString(e), grid);
#else
  for (int ph = 0; ph < 20; ++ph) {
    p.ph_lo = ph; p.ph_hi = ph + 1;
    hipLaunchKernelGGL(mega, dim3(grid), dim3(NTHR), 0, stream, p);
  }
#endif
}
```
